# Optimizing an MI355X kernel written in HIP

```python
import math
import jax, jax.numpy as jnp
from jax import lax
import numpy as np

D_MODEL = 2048
BATCH = 2
SEQ = 4096
DEPTH = 1

MIX_WIDTH = D_MODEL
ATTN_WIDTH = MIX_WIDTH // 2
SSM_WIDTH = MIX_WIDTH - ATTN_WIDTH
ATTN_HEADS = 8
ATTN_HEAD_DIM = ATTN_WIDTH // (2 * ATTN_HEADS)
VALUE_DIM = 2 * ATTN_HEAD_DIM
SSM_GROUP = 16
SSM_GROUPS = SSM_WIDTH // SSM_GROUP
SSM_STATE = 64
D_FF = 5632
CONV_WIDTH = 3
Q_BLOCK = 128
EPS = 1e-6
DT_MIN = 0.001
DT_MAX = 0.1
PROJ_IN = 3 * ATTN_WIDTH + SSM_WIDTH

kernel_name = "hymba_diffattn_s5_convffn_block"


def rms_norm(x, g):
    xf = x.astype(jnp.float32)
    y = xf * lax.rsqrt(jnp.mean(xf * xf, axis=-1, keepdims=True) + EPS)
    return (y * g.astype(jnp.float32)).astype(x.dtype)


def modulate(h, shift, scale):
    return h * (1.0 + scale[:, None, :]) + shift[:, None, :]


def alibi_slopes(n_heads):
    return jnp.asarray([2.0 ** (-8.0 * (i + 1) / n_heads) for i in range(n_heads)], jnp.float32)


def diff_attention(q1, q2, k1, k2, v, lam):
    B, H, L, d = q1.shape
    n_blocks = L // Q_BLOCK
    slopes = alibi_slopes(H)
    key_pos = jnp.arange(L)
    scale = d ** -0.5

    def block(i):
        start = i * Q_BLOCK
        qb1 = lax.dynamic_slice_in_dim(q1, start, Q_BLOCK, axis=2)
        qb2 = lax.dynamic_slice_in_dim(q2, start, Q_BLOCK, axis=2)
        q_pos = start + jnp.arange(Q_BLOCK)
        dist = (q_pos[:, None] - key_pos[None, :]).astype(jnp.float32)
        bias = jnp.where(dist >= 0, -slopes[:, None, None] * dist, -jnp.inf)
        s1 = jnp.einsum('bhqd,bhkd->bhqk', qb1, k1).astype(jnp.float32) * scale + bias
        s2 = jnp.einsum('bhqd,bhkd->bhqk', qb2, k2).astype(jnp.float32) * scale + bias
        w = jax.nn.softmax(s1, axis=-1) - lam * jax.nn.softmax(s2, axis=-1)
        return jnp.einsum('bhqk,bhkv->bhqv', w.astype(v.dtype), v)

    out = lax.map(block, jnp.arange(n_blocks))
    return out.transpose(1, 0, 3, 2, 4).reshape(B, L, H, v.shape[-1])


def complex_affine_combine(e1, e2):
    ar1, ai1, br1, bi1 = e1
    ar2, ai2, br2, bi2 = e2
    ar = ar2 * ar1 - ai2 * ai1
    ai = ar2 * ai1 + ai2 * ar1
    br = ar2 * br1 - ai2 * bi1 + br2
    bi = ar2 * bi1 + ai2 * br1 + bi2
    return (ar, ai, br, bi)


def s5_ssm(u, a_re, a_im, log_dt, b_re, b_im, c_re, c_im, d_skip):
    B, L, _ = u.shape
    f32 = jnp.float32
    uf = u.astype(f32).reshape(B, L, SSM_GROUPS, SSM_GROUP)
    dt = jnp.exp(log_dt.astype(f32))[:, None]
    ar, ai = a_re.astype(f32), a_im.astype(f32)
    mag = jnp.exp(dt * ar)
    abar_re, abar_im = mag * jnp.cos(dt * ai), mag * jnp.sin(dt * ai)
    den = ar * ar + ai * ai
    nr, ni = abar_re - 1.0, abar_im
    coef_re = (nr * ar + ni * ai) / den
    coef_im = (ni * ar - nr * ai) / den
    br, bi = b_re.astype(f32), b_im.astype(f32)
    bbar_re = coef_re[..., None] * br - coef_im[..., None] * bi
    bbar_im = coef_re[..., None] * bi + coef_im[..., None] * br
    bu_re = jnp.einsum('blgc,gpc->blgp', uf, bbar_re)
    bu_im = jnp.einsum('blgc,gpc->blgp', uf, bbar_im)
    a_re_b = jnp.broadcast_to(abar_re, bu_re.shape)
    a_im_b = jnp.broadcast_to(abar_im, bu_im.shape)
    _, _, x_re, x_im = lax.associative_scan(
        complex_affine_combine, (a_re_b, a_im_b, bu_re, bu_im), axis=1)
    y = (jnp.einsum('blgp,gcp->blgc', x_re, c_re.astype(f32))
         - jnp.einsum('blgp,gcp->blgc', x_im, c_im.astype(f32))
         + d_skip.astype(f32).reshape(SSM_GROUPS, SSM_GROUP) * uf)
    return y.reshape(B, L, SSM_WIDTH).astype(u.dtype)


def causal_dwconv(x, w, b):
    y = lax.conv_general_dilated(
        x, w[:, None, :].astype(x.dtype), window_strides=(1,), padding=[(CONV_WIDTH - 1, 0)],
        dimension_numbers=('NWC', 'WIO', 'NWC'), feature_group_count=x.shape[-1])
    return y + b


def setup_inputs(seed: int = 0) -> dict:
    key = jax.random.key(seed)
    ks = jax.random.split(key, 32)
    f32 = jnp.float32

    def nrm(k, shape, s):
        return jax.random.normal(k, shape, f32) * s

    Ld = DEPTH
    P, G, C = SSM_STATE, SSM_GROUPS, SSM_GROUP
    return {
        "x": nrm(ks[0], (BATCH, SEQ, D_MODEL), 1.0),
        "c": nrm(ks[1], (BATCH, D_MODEL), 1.0),
        "w_ada": nrm(ks[2], (Ld, D_MODEL, 6 * D_MODEL), D_MODEL ** -0.5),
        "b_ada": nrm(ks[3], (Ld, 6 * D_MODEL), 0.02),
        "norm1_g": 1.0 + nrm(ks[4], (Ld, D_MODEL), 0.02),
        "norm2_g": 1.0 + nrm(ks[5], (Ld, D_MODEL), 0.02),
        "w_in": nrm(ks[6], (Ld, D_MODEL, PROJ_IN), D_MODEL ** -0.5),
        "q_norm_g": 1.0 + nrm(ks[7], (Ld, ATTN_HEAD_DIM), 0.02),
        "k_norm_g": 1.0 + nrm(ks[8], (Ld, ATTN_HEAD_DIM), 0.02),
        "lambda_q1": nrm(ks[9], (Ld, ATTN_HEAD_DIM), 0.1),
        "lambda_k1": nrm(ks[10], (Ld, ATTN_HEAD_DIM), 0.1),
        "lambda_q2": nrm(ks[11], (Ld, ATTN_HEAD_DIM), 0.1),
        "lambda_k2": nrm(ks[12], (Ld, ATTN_HEAD_DIM), 0.1),
        "attn_sub_norm_g": 1.0 + nrm(ks[13], (Ld, VALUE_DIM), 0.02),
        "ssm_a_re": -0.5 + nrm(ks[14], (Ld, G, P), 0.01),
        "ssm_a_im": math.pi * jnp.arange(P, dtype=f32) + nrm(ks[15], (Ld, G, P), 0.01),
        "ssm_log_dt": jax.random.uniform(ks[16], (Ld, G), f32, math.log(DT_MIN), math.log(DT_MAX)),
        "ssm_b_re": nrm(ks[17], (Ld, G, P, C), (2 * C) ** -0.5),
        "ssm_b_im": nrm(ks[18], (Ld, G, P, C), (2 * C) ** -0.5),
        "ssm_c_re": nrm(ks[19], (Ld, G, C, P), P ** -0.5),
        "ssm_c_im": nrm(ks[20], (Ld, G, C, P), P ** -0.5),
        "ssm_d": nrm(ks[21], (Ld, SSM_WIDTH), 1.0),
        "w_glu": nrm(ks[22], (Ld, SSM_WIDTH, SSM_WIDTH), SSM_WIDTH ** -0.5),
        "b_glu": nrm(ks[23], (Ld, SSM_WIDTH), 0.02),
        "w_out": nrm(ks[24], (Ld, MIX_WIDTH, D_MODEL), MIX_WIDTH ** -0.5),
        "w_up": nrm(ks[25], (Ld, D_MODEL, 2 * D_FF), D_MODEL ** -0.5),
        "conv_w": nrm(ks[26], (Ld, CONV_WIDTH, D_FF), CONV_WIDTH ** -0.5),
        "conv_b": nrm(ks[27], (Ld, D_FF), 0.02),
        "w_down": nrm(ks[28], (Ld, D_FF, D_MODEL), D_FF ** -0.5),
    }


def reference(x, c, w_ada, b_ada, norm1_g, norm2_g, w_in, q_norm_g, k_norm_g,
              lambda_q1, lambda_k1, lambda_q2, lambda_k2, attn_sub_norm_g,
              ssm_a_re, ssm_a_im, ssm_log_dt, ssm_b_re, ssm_b_im, ssm_c_re, ssm_c_im, ssm_d,
              w_glu, b_glu, w_out, w_up, conv_w, conv_b, w_down):
    B, L, _ = x.shape
    H, d = ATTN_HEADS, ATTN_HEAD_DIM
    c_act = jax.nn.silu(c)
    for l in range(DEPTH):
        lambda_init = 0.8 - 0.6 * math.exp(-0.3 * l)
        mod = c_act @ w_ada[l] + b_ada[l]
        shift1, scale1, gate1, shift2, scale2, gate2 = jnp.split(mod, 6, axis=-1)

        h = modulate(rms_norm(x, norm1_g[l]), shift1, scale1)
        proj = h @ w_in[l]
        q, k, v, u = jnp.split(proj, [ATTN_WIDTH, 2 * ATTN_WIDTH, 3 * ATTN_WIDTH], axis=-1)

        q = rms_norm(q.reshape(B, L, H, 2, d), q_norm_g[l]).transpose(3, 0, 2, 1, 4)
        k = rms_norm(k.reshape(B, L, H, 2, d), k_norm_g[l]).transpose(3, 0, 2, 1, 4)
        v = v.reshape(B, L, H, VALUE_DIM).transpose(0, 2, 1, 3)
        lam = (jnp.exp(jnp.sum(lambda_q1[l].astype(jnp.float32) * lambda_k1[l].astype(jnp.float32)))
               - jnp.exp(jnp.sum(lambda_q2[l].astype(jnp.float32) * lambda_k2[l].astype(jnp.float32)))
               + lambda_init)
        attn = diff_attention(q[0], q[1], k[0], k[1], v, lam)
        attn = (rms_norm(attn, attn_sub_norm_g[l]) * (1.0 - lambda_init)).reshape(B, L, ATTN_WIDTH)

        y = s5_ssm(u, ssm_a_re[l], ssm_a_im[l], ssm_log_dt[l], ssm_b_re[l], ssm_b_im[l],
                   ssm_c_re[l], ssm_c_im[l], ssm_d[l])
        y = jax.nn.gelu(y)
        y = y * jax.nn.sigmoid(y @ w_glu[l] + b_glu[l])

        mix = jnp.concatenate([attn, y], axis=-1) @ w_out[l]
        x = x + gate1[:, None, :] * mix

        h = modulate(rms_norm(x, norm2_g[l]), shift2, scale2)
        a, g = jnp.split(h @ w_up[l], 2, axis=-1)
        a = causal_dwconv(a, conv_w[l], conv_b[l])
        ffn = (jax.nn.gelu(a) * g) @ w_down[l]
        x = x + gate2[:, None, :] * ffn
    return x
```

```cpp
#include <hip/hip_runtime.h>
#include <hip/hip_cooperative_groups.h>
#include <cstdio>
#include <cstdint>
namespace cg = cooperative_groups;
namespace pg8 {
#define PG8_LAS __attribute__((address_space(3)))
typedef unsigned short bf16_t;
typedef short bf16x8 __attribute__((ext_vector_type(8)));
typedef float f32x4 __attribute__((ext_vector_type(4)));
typedef unsigned u32x4 __attribute__((ext_vector_type(4)));
constexpr int BM = 256, BK = 64, HALF = 128, HTB = HALF * BK * 2  , STAGE_BYTES = 8 * HTB, NXCD = 8, WGM = 8;

__host__ __device__ __forceinline__ int lds_byte(int r, int c) { const int st = (r >> 4) * 2 + (c >> 5), rr = r & 15, cc = c & 31, ob = rr * 64 + cc * 2; return st * 1024 + (ob ^ (((ob >> 9) & 1) << 5)); }
__host__ __device__ __forceinline__ void stage_rc(int b, int& R, int& C) { const int st = b / 1024, sb = b % 1024, swz = sb ^ (((sb >> 9) & 1) << 5); R = (st >> 1) * 16 + swz / 64; C = (st & 1) * 32 + (swz % 64) / 2; }
__host__ __device__ __forceinline__ int perm32(int rho) { const int n = rho >> 4, i = rho & 15; return 8 * (i >> 2) + 4 * n + (i & 3); }

struct Unit { int pm, pn; };
struct Gemm { const bf16_t* A; const bf16_t* Bt; int M, N, K, lda, ldb; };

struct StaticOrder {
    int nM, nN, nwg, G, c;
    __host__ __device__ void init(int M, int N, int G_, int c_) { nM = M / BM; nN = N / BM; nwg = nM * nN; G = G_; c = c_; }
    __host__ __device__ bool next(int i, Unit& u) const {
        const long L = (long)i * G + c; if (L >= nwg) return false;
        int wgid = (int)L; { const int q = nwg / NXCD, r = nwg % NXCD, xcd = wgid % NXCD, off = wgid / NXCD; wgid = (xcd < r ? xcd * (q + 1) : r * (q + 1) + (xcd - r) * q) + off; }
        const int nig = WGM * nN, gid = wgid / nig, fm = gid * WGM, gsz = (nM - fm) < WGM ? (nM - fm) : WGM;
        u.pm = fm + ((wgid % nig) % gsz); u.pn = (wgid % nig) / gsz; return true;
    }
    __device__ __forceinline__ void a_ready(const Unit&) const {}
    __device__ __forceinline__ void done(const Unit&) const {}
};

__device__ __forceinline__ unsigned cvt_pk_bf16(float lo, float hi) { unsigned r; asm volatile("v_cvt_pk_bf16_f32 %0, %1, %2" : "=v"(r) : "v"(lo), "v"(hi)); return r; }
typedef float f32x2 __attribute__((ext_vector_type(2)));
__device__ __forceinline__ f32x2 gelu_pk(f32x2 v) {
    const f32x2 av = __builtin_elementwise_abs(v), d = av * 0.2316418882f + 1.0f;
    f32x2 t; t.x = __builtin_amdgcn_rcpf(d.x); t.y = __builtin_amdgcn_rcpf(d.y);
    f32x2 q = t * 0.5307027145f + (-0.7265760135f); q = q * t + 0.7107068705f; q = q * t + (-0.142248368f); q = q * t + 0.127414796f; q = q * t;
    const f32x2 s = (v * v) * (-0.72134752044f);
    f32x2 e; e.x = __builtin_amdgcn_exp2f(s.x); e.y = __builtin_amdgcn_exp2f(s.y);
    const f32x2 m = v * (q * e), r = v - m;
    f32x2 o; o.x = v.x < 0.f ? m.x : r.x; o.y = v.y < 0.f ? m.y : r.y; return o;
}

template <int ACT  > struct EpiBf16 {
    static constexpr bool PERM = true, AFTER_DRAIN = false; static_assert(ACT == 0 || ACT == 1, "EpiBf16: ACT is 0 (none) or 1 (gelu_pk)");
    bf16_t* O; int ldc; const float* bias; int split_cols; size_t split_stride; float scale0;
    __device__ __forceinline__ void operator()(const f32x4 (&acc)[2][2][4][2], const Unit& u, int wr, int wc, int fr, int fq) const {
        const int row0 = u.pm * BM + wr * 64 + fr; int colt = u.pn * BM; bf16_t* base = O;
        float sc = 1.f; if (split_cols) { const int t = colt / split_cols; base += (size_t)t * split_stride; colt -= t * split_cols; if (t == 0) sc = scale0; }
        const int col0 = colt + wc * 32 + 8 * fq, bcol0 = u.pn * BM + wc * 32 + 8 * fq;
        f32x4 bv[2][2];
#pragma unroll
        for (int bj = 0; bj < 2; ++bj)
#pragma unroll
            for (int n = 0; n < 2; ++n) bv[bj][n] = bias ? *(const f32x4*)(bias + bcol0 + bj * HALF + 4 * n) : (f32x4){0.f, 0.f, 0.f, 0.f};
#pragma unroll
        for (int ai = 0; ai < 2; ++ai)
#pragma unroll
            for (int m = 0; m < 4; ++m) { bf16_t* rowp = base + (size_t)(row0 + ai * HALF + m * 16) * ldc + col0;
#pragma unroll
                for (int bj = 0; bj < 2; ++bj) { f32x4 v0 = acc[ai][bj][m][0] + bv[bj][0], v1 = acc[ai][bj][m][1] + bv[bj][1];
                    if (ACT == 1) { f32x2 a = gelu_pk((f32x2){v0[0], v0[1]}), b = gelu_pk((f32x2){v0[2], v0[3]}), c = gelu_pk((f32x2){v1[0], v1[1]}), d = gelu_pk((f32x2){v1[2], v1[3]});
                        v0 = (f32x4){a.x, a.y, b.x, b.y}; v1 = (f32x4){c.x, c.y, d.x, d.y}; }
                    v0 = v0 * sc; v1 = v1 * sc; u32x4 w; w.x = cvt_pk_bf16(v0[0], v0[1]); w.y = cvt_pk_bf16(v0[2], v0[3]); w.z = cvt_pk_bf16(v1[0], v1[1]); w.w = cvt_pk_bf16(v1[2], v1[3]);
                    *(u32x4*)(rowp + bj * HALF) = w; } }
    }
};
template <class Epi, class Sched, bool ALIGN_EPI = false, bool SP2 = false>
__device__ __forceinline__ void gemm_phase(PG8_LAS unsigned char* lds, const Gemm g, const Sched& S, const Epi& E) {
    int tid_o = threadIdx.x; asm volatile("" : "+v"(tid_o));
    const int tid = tid_o, wid = __builtin_amdgcn_readfirstlane(tid >> 6), lane = tid & 63, wr = wid >> 2, wc = wid & 3, fr = lane & 15, fq = lane >> 4;
    const int K = g.K, nt = K / BK;
    unsigned voffA[2], voffB[2];
#pragma unroll
    for (int i = 0; i < 2; ++i) { int R, C; stage_rc(tid * 16 + i * 8192, R, C); const int Rb = Epi::PERM ? ((R & ~31) + perm32(R & 31)) : R;
        voffA[i] = (unsigned)(R * g.lda + C) * 2u; voffB[i] = (unsigned)(Rb * g.ldb + C) * 2u; }
    const size_t kstep = (size_t)(BK * 2);
    const size_t hstepA = (size_t)HALF * g.lda * 2, hstepB = (size_t)HALF * g.ldb * 2;
    const size_t tstepA = 2 * hstepA, tstepB = 2 * hstepB;
    const unsigned ldsw = (unsigned)wid * 1024u;
    const int aoff = lds_byte(wr * 64 + fr, fq * 8), boff = lds_byte(wc * 32 + fr, fq * 8);
#define PG8_SA(b, h) (((b) * 2 + (h)) * HTB)
#define PG8_SB(b, h) ((4 + (b) * 2 + (h)) * HTB)
#define PG8_STAGE(bufoff, gbase, voff) do { _Pragma("unroll") for (int _i = 0; _i < 2; ++_i) \
        __builtin_amdgcn_global_load_lds((const unsigned*)((const char*)(gbase) + (voff)[_i]), (PG8_LAS unsigned*)(lds + (bufoff) + ldsw + _i * 8192), 16, 0, 0); } while (0)
#define PG8_LDA(dst, b, h) do { _Pragma("unroll") for (int m = 0; m < 4; ++m) _Pragma("unroll") for (int k = 0; k < 2; ++k) dst[m][k] = *(const PG8_LAS bf16x8*)(lds + PG8_SA(b, h) + aoff + m * 2048 + k * 1024); } while (0)
#define PG8_LDB(dst, b, h) do { _Pragma("unroll") for (int n = 0; n < 2; ++n) _Pragma("unroll") for (int k = 0; k < 2; ++k) dst[n][k] = *(const PG8_LAS bf16x8*)(lds + PG8_SB(b, h) + boff + n * 2048 + k * 1024); } while (0)
#define PG8_MMA(ai, bj, At, Bt) do { __builtin_amdgcn_s_setprio(1); _Pragma("unroll") for (int m = 0; m < 4; ++m) _Pragma("unroll") for (int n = 0; n < 2; ++n) _Pragma("unroll") for (int k = 0; k < 2; ++k) \
        acc[ai][bj][m][n] = __builtin_amdgcn_mfma_f32_16x16x32_bf16(Bt[n][k], At[m][k], acc[ai][bj][m][n], 0, 0, 0); __builtin_amdgcn_s_setprio(0); } while (0)
#define PG8_WAIT_V(n) asm volatile("s_waitcnt vmcnt(" #n ")" ::: "memory")
#define PG8_WAIT_L(n) asm volatile("s_waitcnt lgkmcnt(" #n ")" ::: "memory")
#define PG8_BAR __builtin_amdgcn_s_barrier()
#define PG8_SCHED __builtin_amdgcn_sched_barrier(0)
    Unit cur, nxt; int ui = 0;
    if (!S.next(0, cur)) return;
    f32x4 acc[2][2][4][2];
#pragma unroll
    for (int a = 0; a < 2; ++a)
#pragma unroll
        for (int b = 0; b < 2; ++b)
#pragma unroll
            for (int m = 0; m < 4; ++m)
#pragma unroll
                for (int n = 0; n < 2; ++n) acc[a][b][m][n] = (f32x4){0.f, 0.f, 0.f, 0.f};
    bf16x8 At[4][2], B0[2][2], B1[2][2];
    const char* cA = (const char*)g.A + (size_t)cur.pm * tstepA; const char* cB = (const char*)g.Bt + (size_t)cur.pn * tstepB;
    S.a_ready(cur);
    if constexpr (SP2) {
        PG8_STAGE(PG8_SB(0, 0), cB, voffB); PG8_STAGE(PG8_SB(0, 1), cB + hstepB, voffB); PG8_STAGE(PG8_SA(0, 0), cA, voffA); PG8_STAGE(PG8_SA(0, 1), cA + hstepA, voffA);
        if (wr == 1) PG8_BAR;
        PG8_WAIT_V(2); PG8_BAR;
        PG8_STAGE(PG8_SB(1, 0), cB + kstep, voffB); PG8_STAGE(PG8_SA(1, 0), cA + kstep, voffA); PG8_STAGE(PG8_SB(1, 1), cB + hstepB + kstep, voffB);
        PG8_WAIT_V(6); PG8_BAR;
    } else {
        PG8_STAGE(PG8_SB(0, 0), cB, voffB); PG8_STAGE(PG8_SA(0, 0), cA, voffA); PG8_STAGE(PG8_SB(0, 1), cB + hstepB, voffB); PG8_STAGE(PG8_SA(0, 1), cA + hstepA, voffA);
        if (wr == 1) PG8_BAR;
        PG8_WAIT_V(4); PG8_BAR;
        PG8_STAGE(PG8_SB(1, 0), cB + kstep, voffB); PG8_STAGE(PG8_SA(1, 0), cA + kstep, voffA); PG8_STAGE(PG8_SB(1, 1), cB + hstepB + kstep, voffB);
        PG8_WAIT_V(6); PG8_BAR;
    }
    for (;;) {
        const bool has_next = S.next(ui + 1, nxt);
        const char* nA = has_next ? (const char*)g.A + (size_t)nxt.pm * tstepA : cA; const char* nB = has_next ? (const char*)g.Bt + (size_t)nxt.pn * tstepB : cB;
        for (int t = 0; t < nt; t += 2) {
            const bool last = (t == nt - 2);
            const char* a1 = cA + (size_t)(t + 1) * kstep;
            const char* a2 = last ? nA : cA + (size_t)(t + 2) * kstep; const char* b2 = last ? nB : cB + (size_t)(t + 2) * kstep;
            const char* a3 = a2 + kstep; const char* b3 = b2 + kstep;
            if (last && has_next) S.a_ready(nxt);
            if constexpr (SP2) {
            PG8_LDB(B0, 0, 0); PG8_LDB(B1, 0, 1); PG8_SCHED; PG8_LDA(At, 0, 0); PG8_STAGE(PG8_SA(1, 1), a1 + hstepA, voffA);
            PG8_WAIT_V(8); PG8_WAIT_L(0); PG8_BAR; PG8_MMA(0, 0, At, B0); PG8_MMA(0, 1, At, B1); PG8_BAR; PG8_SCHED;
            PG8_LDA(At, 0, 1); PG8_STAGE(PG8_SB(0, 0), b2, voffB); PG8_STAGE(PG8_SB(0, 1), b2 + hstepB, voffB); PG8_STAGE(PG8_SA(0, 0), a2, voffA);
            PG8_WAIT_V(8); PG8_WAIT_L(0); PG8_BAR; PG8_MMA(1, 0, At, B0); PG8_MMA(1, 1, At, B1); PG8_BAR; PG8_SCHED;
            PG8_LDB(B0, 1, 0); PG8_LDB(B1, 1, 1); PG8_SCHED; PG8_LDA(At, 1, 0); PG8_STAGE(PG8_SA(0, 1), a2 + hstepA, voffA);
            PG8_WAIT_V(8); PG8_WAIT_L(0); PG8_BAR; PG8_MMA(0, 0, At, B0); PG8_MMA(0, 1, At, B1); PG8_BAR; PG8_SCHED;
            PG8_LDA(At, 1, 1); PG8_STAGE(PG8_SB(1, 0), b3, voffB); PG8_STAGE(PG8_SB(1, 1), b3 + hstepB, voffB); PG8_STAGE(PG8_SA(1, 0), a3, voffA);
            PG8_WAIT_V(8); PG8_WAIT_L(0); PG8_BAR; PG8_MMA(1, 0, At, B0); PG8_MMA(1, 1, At, B1); PG8_BAR; PG8_SCHED;
            } else {
            PG8_LDB(B0, 0, 0); PG8_SCHED; PG8_LDA(At, 0, 0); PG8_STAGE(PG8_SA(1, 1), a1 + hstepA, voffA);
            PG8_WAIT_L(8); PG8_BAR; PG8_WAIT_L(0); PG8_MMA(0, 0, At, B0); PG8_BAR; PG8_SCHED;
            PG8_LDB(B1, 0, 1); PG8_STAGE(PG8_SB(0, 0), b2, voffB);
            PG8_BAR; PG8_WAIT_L(0); PG8_MMA(0, 1, At, B1); PG8_BAR;
            PG8_LDA(At, 0, 1); PG8_STAGE(PG8_SA(0, 0), a2, voffA);
            PG8_BAR; PG8_WAIT_L(0); PG8_MMA(1, 0, At, B0); PG8_BAR; PG8_SCHED;
            PG8_STAGE(PG8_SB(0, 1), b2 + hstepB, voffB);
            PG8_WAIT_V(6); PG8_BAR; PG8_MMA(1, 1, At, B1); PG8_BAR;
            PG8_LDB(B0, 1, 0); PG8_SCHED; PG8_LDA(At, 1, 0); PG8_STAGE(PG8_SA(0, 1), a2 + hstepA, voffA);
            PG8_WAIT_L(8); PG8_BAR; PG8_WAIT_L(0); PG8_MMA(0, 0, At, B0); PG8_BAR; PG8_SCHED;
            PG8_LDB(B1, 1, 1); PG8_STAGE(PG8_SB(1, 0), b3, voffB);
            PG8_BAR; PG8_WAIT_L(0); PG8_MMA(0, 1, At, B1); PG8_BAR;
            PG8_LDA(At, 1, 1); PG8_STAGE(PG8_SA(1, 0), a3, voffA);
            PG8_BAR; PG8_WAIT_L(0); PG8_MMA(1, 0, At, B0); PG8_BAR; PG8_SCHED;
            PG8_STAGE(PG8_SB(1, 1), b3 + hstepB, voffB);
            PG8_WAIT_V(6); PG8_BAR; PG8_MMA(1, 1, At, B1); PG8_BAR;
            }
        }
        if constexpr (ALIGN_EPI) { if (wr == 0) PG8_BAR; }
        if constexpr (!Epi::AFTER_DRAIN) { E(acc, cur, wr, wc, fr, fq); S.done(cur); }
        if (!has_next) break;
#pragma unroll
        for (int a = 0; a < 2; ++a)
#pragma unroll
            for (int b = 0; b < 2; ++b)
#pragma unroll
                for (int m = 0; m < 4; ++m)
#pragma unroll
                    for (int n = 0; n < 2; ++n) acc[a][b][m][n] = (f32x4){0.f, 0.f, 0.f, 0.f};
        cur = nxt; cA = nA; cB = nB; ++ui;
        if constexpr (ALIGN_EPI) { if (wr == 1) PG8_BAR; }
    }
    PG8_WAIT_V(0);
    if constexpr (!ALIGN_EPI) { if (wr == 0) PG8_BAR; }
    PG8_BAR;
    if constexpr (Epi::AFTER_DRAIN) { E.fused(acc, cur, wr, wc, fr, fq, lds, wid, lane); S.done(cur); }
#undef PG8_SA
#undef PG8_SB
#undef PG8_STAGE
#undef PG8_LDA
#undef PG8_LDB
#undef PG8_MMA
#undef PG8_WAIT_V
#undef PG8_WAIT_L
#undef PG8_BAR
#undef PG8_SCHED
}
}

namespace pg8 {
struct EpiF32 {
    static constexpr bool PERM = true, AFTER_DRAIN = false;
    float* O; int ldc;
    __device__ __forceinline__ void operator()(const f32x4 (&acc)[2][2][4][2], const Unit& u, int wr, int wc, int fr, int fq) const {
        const int row0 = u.pm * BM + wr * 64 + fr, col0 = u.pn * BM + wc * 32 + 8 * fq;
#pragma unroll
        for (int ai = 0; ai < 2; ++ai)
#pragma unroll
            for (int m = 0; m < 4; ++m) { float* rowp = O + (size_t)(row0 + ai * HALF + m * 16) * ldc + col0;
#pragma unroll
                for (int bj = 0; bj < 2; ++bj) { *(f32x4*)(rowp + bj * HALF) = acc[ai][bj][m][0]; *(f32x4*)(rowp + bj * HALF + 4) = acc[ai][bj][m][1]; } }
    }
};

struct XcdOrder {
    int ppx, ntile, rank, nb, pm0;
    __device__ void init(int M, int N, int vx, int rank_, int nb_) { ppx = (M / BM) / NXCD; ntile = ppx * (N / BM); rank = rank_; nb = nb_; pm0 = vx * ppx; }
    __device__ bool next(int i, Unit& u) const { const int t = rank + i * nb; if (t >= ntile) return false; u.pm = pm0 + t % ppx; u.pn = t / ppx; return true; }
    __device__ __forceinline__ void a_ready(const Unit&) const {}
    __device__ __forceinline__ void done(const Unit&) const {}
};
struct VtOrder {
    int vx, r2, nb2;
    __device__ void init(int vx_, int rank, int nb) { vx = vx_; r2 = rank - nb / 2; nb2 = nb - nb / 2; }
    __device__ bool next(int i, Unit& u) const { if (r2 < 0) return false; const int t = r2 + i * nb2; if (t >= 16) return false; u.pm = t & 3; u.pn = vx * 4 + (t >> 2); return true; }
    __device__ __forceinline__ void a_ready(const Unit&) const {}
    __device__ __forceinline__ void done(const Unit&) const {}
};
struct EpiUp {
    static constexpr bool PERM = true, AFTER_DRAIN = false;
    bf16_t* O; int ldc; bf16_t* side; int acols;
    __device__ __forceinline__ void operator()(const f32x4 (&acc)[2][2][4][2], const Unit& u, int wr, int wc, int fr, int fq) const {
        const int row0 = u.pm * BM + wr * 64 + fr, col0 = u.pn * BM + wc * 32 + 8 * fq;
#pragma unroll
        for (int ai = 0; ai < 2; ++ai)
#pragma unroll
            for (int m = 0; m < 4; ++m) { const int row = row0 + ai * HALF + m * 16; bf16_t* rowp = O + (size_t)row * ldc + col0;
#pragma unroll
                for (int bj = 0; bj < 2; ++bj) { const f32x4 v0 = acc[ai][bj][m][0], v1 = acc[ai][bj][m][1];
                    u32x4 w; w.x = cvt_pk_bf16(v0[0], v0[1]); w.y = cvt_pk_bf16(v0[2], v0[3]); w.z = cvt_pk_bf16(v1[0], v1[1]); w.w = cvt_pk_bf16(v1[2], v1[3]);
                    *(u32x4*)(rowp + bj * HALF) = w;
                    if ((row & 1023) >= 1022 && col0 + bj * HALF < acols) *(u32x4*)(side + ((size_t)(row >> 10) * 2 + (row & 1)) * acols + col0 + bj * HALF) = w; } }
    }
};

struct DiagOrder {
    int vb, nvb;
    __device__ bool next(int i, Unit& u) const { const int t = vb + i * nvb; if (t >= 128) return false; u.pm = t; u.pn = t >> 1; return true; }
    __device__ __forceinline__ void a_ready(const Unit&) const {}
    __device__ __forceinline__ void done(const Unit&) const {}
};
struct EpiS {
    static constexpr bool PERM = true, AFTER_DRAIN = false;
    float* S;
    __device__ __forceinline__ void operator()(const f32x4 (&acc)[2][2][4][2], const Unit& u, int wr, int wc, int fr, int fq) const {
        const int row0 = u.pm * BM + wr * 64 + fr, col0 = wc * 32 + 8 * fq;
#pragma unroll
        for (int ai = 0; ai < 2; ++ai)
#pragma unroll
            for (int m = 0; m < 4; ++m) { float* rowp = S + (size_t)(row0 + ai * HALF + m * 16) * 128 + col0; *(f32x4*)rowp = acc[ai][0][m][0]; *(f32x4*)(rowp + 4) = acc[ai][0][m][1]; }
    }
};
struct EpiY {
    static constexpr bool PERM = true, AFTER_DRAIN = false;
    const bf16_t* UX; const float* dsk; bf16_t* YG;
    __device__ __forceinline__ void operator()(const f32x4 (&acc)[2][2][4][2], const Unit& u, int wr, int wc, int fr, int fq) const {
        const int g = u.pn, row0 = u.pm * BM + wr * 64 + fr;
#pragma unroll
        for (int bj = 0; bj < 2; ++bj) {
            const int col = bj * HALF + wc * 32 + 8 * fq, t = col >> 4, c0 = col & 15;
            const f32x4 d0 = *(const f32x4*)(dsk + g * 16 + c0), d1 = *(const f32x4*)(dsk + g * 16 + c0 + 4);
            u32x4 uwv[2][4];
#pragma unroll
            for (int ai = 0; ai < 2; ++ai)
#pragma unroll
                for (int m = 0; m < 4; ++m) uwv[ai][m] = *(const u32x4*)(UX + (size_t)(row0 + ai * HALF + m * 16) * 384 + col);
#pragma unroll
            for (int ai = 0; ai < 2; ++ai)
#pragma unroll
                for (int m = 0; m < 4; ++m) {
                    const int row = row0 + ai * HALF + m * 16, seq = row - g * 512;
                    const u32x4 uw = uwv[ai][m];
                    const f32x4 a0 = acc[ai][bj][m][0], a1 = acc[ai][bj][m][1];
                    float y[8];
                    y[0] = a0[0] + d0[0] * __builtin_bit_cast(float, uw.x << 16); y[1] = a0[1] + d0[1] * __builtin_bit_cast(float, uw.x & 0xffff0000u);
                    y[2] = a0[2] + d0[2] * __builtin_bit_cast(float, uw.y << 16); y[3] = a0[3] + d0[3] * __builtin_bit_cast(float, uw.y & 0xffff0000u);
                    y[4] = a1[0] + d1[0] * __builtin_bit_cast(float, uw.z << 16); y[5] = a1[1] + d1[1] * __builtin_bit_cast(float, uw.z & 0xffff0000u);
                    y[6] = a1[2] + d1[2] * __builtin_bit_cast(float, uw.w << 16); y[7] = a1[3] + d1[3] * __builtin_bit_cast(float, uw.w & 0xffff0000u);
#pragma unroll
                    for (int e = 0; e < 8; ++e) { const float x = y[e], q = 0.7978845608028654f * (x + 0.044715f * x * x * x); y[e] = x * __builtin_amdgcn_rcpf(1.0f + __builtin_amdgcn_exp2f(-2.885390081777927f * q)); }
                    u32x4 w; w.x = cvt_pk_bf16(y[0], y[1]); w.y = cvt_pk_bf16(y[2], y[3]); w.z = cvt_pk_bf16(y[4], y[5]); w.w = cvt_pk_bf16(y[6], y[7]);
                    { bf16_t* yp = YG + ((size_t)seq * 16 + t) * 1024 + g * 16 + c0; asm volatile("global_store_dwordx4 %0, %1, off sc1\n\ts_nop 1" :: "v"(yp), "v"(w) : "memory"); }
                }
            asm volatile("" ::: "memory");
        }
    }
};

struct EpiRes {
    static constexpr bool PERM = true, AFTER_DRAIN = false;
    const float* base; const float* gate; float* O; int ldc;
    __device__ __forceinline__ void operator()(const f32x4 (&acc)[2][2][4][2], const Unit& u, int wr, int wc, int fr, int fq) const {
        const int row0 = u.pm * BM + wr * 64 + fr, col0 = u.pn * BM + wc * 32 + 8 * fq; const float* gp = gate + ((u.pm * BM) >> 12) * 12288 + col0;
        f32x4 gv[2][2];
#pragma unroll
        for (int bj = 0; bj < 2; ++bj) { gv[bj][0] = *(const f32x4*)(gp + bj * HALF); gv[bj][1] = *(const f32x4*)(gp + bj * HALF + 4); }
#pragma unroll
        for (int ai = 0; ai < 2; ++ai) {
            f32x4 xv[4][2][2];
#pragma unroll
            for (int m = 0; m < 4; ++m) { const size_t off = (size_t)(row0 + ai * HALF + m * 16) * ldc + col0;
#pragma unroll
                for (int bj = 0; bj < 2; ++bj) { xv[m][bj][0] = *(const f32x4*)(base + off + bj * HALF); xv[m][bj][1] = *(const f32x4*)(base + off + bj * HALF + 4); } }
#pragma unroll
            for (int m = 0; m < 4; ++m) { const size_t off = (size_t)(row0 + ai * HALF + m * 16) * ldc + col0;
#pragma unroll
                for (int bj = 0; bj < 2; ++bj) { *(f32x4*)(O + off + bj * HALF) = xv[m][bj][0] + gv[bj][0] * acc[ai][bj][m][0]; *(f32x4*)(O + off + bj * HALF + 4) = xv[m][bj][1] + gv[bj][1] * acc[ai][bj][m][1]; } }
            asm volatile("" ::: "memory");
        }
    }
};
struct EpiGlu {
    static constexpr bool PERM = true, AFTER_DRAIN = false;
    const bf16_t* Y; int ldy; const float* bias; bf16_t* O; int ldo;
    __device__ __forceinline__ void operator()(const f32x4 (&acc)[2][2][4][2], const Unit& u, int wr, int wc, int fr, int fq) const {
        const int row0 = u.pm * BM + wr * 64 + fr, col0 = u.pn * BM + wc * 32 + 8 * fq;
        f32x4 bv[2][2];
#pragma unroll
        for (int bj = 0; bj < 2; ++bj) { bv[bj][0] = *(const f32x4*)(bias + col0 + bj * HALF); bv[bj][1] = *(const f32x4*)(bias + col0 + bj * HALF + 4); }
#pragma unroll
        for (int ai = 0; ai < 2; ++ai) {
            u32x4 ywv[4][2];
#pragma unroll
            for (int m = 0; m < 4; ++m)
#pragma unroll
                for (int bj = 0; bj < 2; ++bj) ywv[m][bj] = *(const u32x4*)(Y + (size_t)(row0 + ai * HALF + m * 16) * ldy + col0 + bj * HALF);
#pragma unroll
            for (int m = 0; m < 4; ++m) { const int row = row0 + ai * HALF + m * 16;
#pragma unroll
                for (int bj = 0; bj < 2; ++bj) { const int col = col0 + bj * HALF; const u32x4 yw = ywv[m][bj];
                    const f32x4 z0 = acc[ai][bj][m][0] + bv[bj][0], z1 = acc[ai][bj][m][1] + bv[bj][1]; float o[8];
                    o[0] = __builtin_bit_cast(float, yw.x << 16) * __builtin_amdgcn_rcpf(1.f + __builtin_amdgcn_exp2f(-1.4426950408889634f * z0[0])); o[1] = __builtin_bit_cast(float, yw.x & 0xffff0000u) * __builtin_amdgcn_rcpf(1.f + __builtin_amdgcn_exp2f(-1.4426950408889634f * z0[1]));
                    o[2] = __builtin_bit_cast(float, yw.y << 16) * __builtin_amdgcn_rcpf(1.f + __builtin_amdgcn_exp2f(-1.4426950408889634f * z0[2])); o[3] = __builtin_bit_cast(float, yw.y & 0xffff0000u) * __builtin_amdgcn_rcpf(1.f + __builtin_amdgcn_exp2f(-1.4426950408889634f * z0[3]));
                    o[4] = __builtin_bit_cast(float, yw.z << 16) * __builtin_amdgcn_rcpf(1.f + __builtin_amdgcn_exp2f(-1.4426950408889634f * z1[0])); o[5] = __builtin_bit_cast(float, yw.z & 0xffff0000u) * __builtin_amdgcn_rcpf(1.f + __builtin_amdgcn_exp2f(-1.4426950408889634f * z1[1]));
                    o[6] = __builtin_bit_cast(float, yw.w << 16) * __builtin_amdgcn_rcpf(1.f + __builtin_amdgcn_exp2f(-1.4426950408889634f * z1[2])); o[7] = __builtin_bit_cast(float, yw.w & 0xffff0000u) * __builtin_amdgcn_rcpf(1.f + __builtin_amdgcn_exp2f(-1.4426950408889634f * z1[3]));
                    u32x4 w; w.x = cvt_pk_bf16(o[0], o[1]); w.y = cvt_pk_bf16(o[2], o[3]); w.z = cvt_pk_bf16(o[4], o[5]); w.w = cvt_pk_bf16(o[6], o[7]);
                    *(u32x4*)(O + (size_t)row * ldo + col) = w; } }
            asm volatile("" ::: "memory"); }
    }
};

struct EpiQKU {
    static constexpr bool PERM = true, AFTER_DRAIN = false;
    bf16_t* QB; bf16_t* KB; bf16_t* UX; const float* qg; const float* kg; float qscale, eps;
    __device__ __forceinline__ void operator()(const f32x4 (&acc)[2][2][4][2], const Unit& u, int wr, int wc, int fr, int fq) const {
        const int row0 = u.pm * BM + wr * 64 + fr, kind = u.pn >> 2, lc0 = (u.pn & 3) * BM + 64 * wc + 8 * fq;
        if (kind < 2) {
            const float* gp = kind == 0 ? qg : kg; const float gs = kind == 0 ? qscale : 1.0f; bf16_t* O = kind == 0 ? QB : KB;
            f32x4 gv[2][2];
#pragma unroll
            for (int bj = 0; bj < 2; ++bj) { gv[bj][0] = *(const f32x4*)(gp + 32 * bj + 8 * fq) * gs; gv[bj][1] = *(const f32x4*)(gp + 32 * bj + 8 * fq + 4) * gs; }
#pragma unroll
            for (int ai = 0; ai < 2; ++ai)
#pragma unroll
                for (int m = 0; m < 4; ++m) {
                    float ss = 0.f;
#pragma unroll
                    for (int bj = 0; bj < 2; ++bj)
#pragma unroll
                        for (int n = 0; n < 2; ++n) { const f32x4 x = acc[ai][bj][m][n]; ss += (x[0] * x[0] + x[1] * x[1]) + (x[2] * x[2] + x[3] * x[3]); }
                    ss += __shfl_xor(ss, 16); ss += __shfl_xor(ss, 32);
                    const float rs = rsqrtf(ss * (1.0f / 64.0f) + eps);
                    bf16_t* rowp = O + (size_t)(row0 + ai * HALF + m * 16) * 1024 + lc0;
#pragma unroll
                    for (int bj = 0; bj < 2; ++bj) { const f32x4 v0 = acc[ai][bj][m][0] * rs * gv[bj][0], v1 = acc[ai][bj][m][1] * rs * gv[bj][1];
                        u32x4 w; w.x = cvt_pk_bf16(v0[0], v0[1]); w.y = cvt_pk_bf16(v0[2], v0[3]); w.z = cvt_pk_bf16(v1[0], v1[1]); w.w = cvt_pk_bf16(v1[2], v1[3]);
                        *(u32x4*)(rowp + 32 * bj) = w; }
                }
        } else {
#pragma unroll
            for (int ai = 0; ai < 2; ++ai)
#pragma unroll
                for (int m = 0; m < 4; ++m) { const int row = row0 + ai * HALF + m * 16;
#pragma unroll
                    for (int bj = 0; bj < 2; ++bj) { const int lu = lc0 + 32 * bj, g = lu >> 4, c0 = lu & 15; const f32x4 v0 = acc[ai][bj][m][0], v1 = acc[ai][bj][m][1];
                        u32x4 w; w.x = cvt_pk_bf16(v0[0], v0[1]); w.y = cvt_pk_bf16(v0[2], v0[3]); w.z = cvt_pk_bf16(v1[0], v1[1]); w.w = cvt_pk_bf16(v1[2], v1[3]);
                        *(u32x4*)(UX + ((size_t)g * 512 + (row >> 4)) * 384 + (row & 15) * 16 + c0) = w; } }
        }
    }
};

__device__ __forceinline__ float dpp_ror1(float v) { return __builtin_bit_cast(float, __builtin_amdgcn_update_dpp(0, __builtin_bit_cast(int, v), 0x121, 0xf, 0xf, false)); }
__device__ __forceinline__ float dpp_ror2(float v) { return __builtin_bit_cast(float, __builtin_amdgcn_update_dpp(0, __builtin_bit_cast(int, v), 0x122, 0xf, 0xf, false)); }
struct EpiUpAct {
    static constexpr bool PERM = true, AFTER_DRAIN = false;
    bf16_t* ACT; bf16_t* sideA; bf16_t* sideB; const float* cw; const float* cbias; int nf;
    __device__ __forceinline__ void operator()(const f32x4 (&acc)[2][2][4][2], const Unit& u, int wr, int wc, int fr, int fq) const {
        const int f0 = u.pn * HALF + wc * 32 + 8 * fq;
        float w0[8], w1[8], w2[8], cb[8];
#pragma unroll
        for (int h = 0; h < 2; ++h) { const f32x4 a = *(const f32x4*)(cw + f0 + 4 * h), b = *(const f32x4*)(cw + nf + f0 + 4 * h), c = *(const f32x4*)(cw + 2 * nf + f0 + 4 * h), d = *(const f32x4*)(cbias + f0 + 4 * h);
#pragma unroll
            for (int e = 0; e < 4; ++e) { w0[4 * h + e] = a[e]; w1[4 * h + e] = b[e]; w2[4 * h + e] = c[e]; cb[4 * h + e] = d[e]; } }
#pragma unroll
        for (int ai = 0; ai < 2; ++ai) {
            const int rowb = u.pm * BM + ai * HALF + wr * 64, blk = rowb >> 6;
#pragma unroll
            for (int m = 0; m < 4; ++m) {
                const int row = rowb + m * 16 + fr;
                float o[8];
#pragma unroll
                for (int e = 0; e < 8; ++e) {
                    const float cur = acc[ai][0][m][e >> 2][e & 3], prv = (m > 0) ? acc[ai][0][m > 0 ? m - 1 : 0][e >> 2][e & 3] : 0.f, gg = acc[ai][1][m][e >> 2][e & 3];
                    const float p1 = dpp_ror1(fr == 15 ? prv : cur), p2 = dpp_ror2(fr >= 14 ? prv : cur);
                    const float x = w0[e] * p2 + w1[e] * p1 + w2[e] * cur + cb[e];
                    const float q = 0.7978845608028654f * (x + 0.044715f * x * x * x);
                    o[e] = x * __builtin_amdgcn_rcpf(1.0f + __builtin_amdgcn_exp2f(-2.885390081777927f * q)) * gg;
                }
                if (m > 0 || fr >= 2) { u32x4 w; w.x = cvt_pk_bf16(o[0], o[1]); w.y = cvt_pk_bf16(o[2], o[3]); w.z = cvt_pk_bf16(o[4], o[5]); w.w = cvt_pk_bf16(o[6], o[7]);
                    *(u32x4*)(ACT + (size_t)row * nf + f0) = w; }
                else { const f32x4 a0 = acc[ai][0][0][0], a1 = acc[ai][0][0][1], g0 = acc[ai][1][0][0], g1 = acc[ai][1][0][1];
                    u32x4 wa, wg; wa.x = cvt_pk_bf16(a0[0], a0[1]); wa.y = cvt_pk_bf16(a0[2], a0[3]); wa.z = cvt_pk_bf16(a1[0], a1[1]); wa.w = cvt_pk_bf16(a1[2], a1[3]);
                    wg.x = cvt_pk_bf16(g0[0], g0[1]); wg.y = cvt_pk_bf16(g0[2], g0[3]); wg.z = cvt_pk_bf16(g1[0], g1[1]); wg.w = cvt_pk_bf16(g1[2], g1[3]);
                    bf16_t* sb = sideB + ((size_t)(blk * 2 + fr) * 2) * nf + f0; *(u32x4*)sb = wa; *(u32x4*)(sb + nf) = wg; }
                if (m == 3 && fr >= 14) { const f32x4 a0 = acc[ai][0][3][0], a1 = acc[ai][0][3][1];
                    u32x4 wa; wa.x = cvt_pk_bf16(a0[0], a0[1]); wa.y = cvt_pk_bf16(a0[2], a0[3]); wa.z = cvt_pk_bf16(a1[0], a1[1]); wa.w = cvt_pk_bf16(a1[2], a1[3]);
                    *(u32x4*)(sideA + (size_t)(blk * 2 + (fr - 14)) * nf + f0) = wa; }
            }
        }
    }
};

struct OneUnit {
    int pm, pn;
    __device__ bool next(int i, Unit& u) const { if (i) return false; u.pm = pm; u.pn = pn; return true; }
    __device__ __forceinline__ void a_ready(const Unit&) const {}
    __device__ __forceinline__ void done(const Unit&) const {}
};

struct EpiResOutB {
    static constexpr bool PERM = true, AFTER_DRAIN = false;
    const float* base; const float* gate; bf16_t* O; int ldc;
    __device__ __forceinline__ void operator()(const f32x4 (&acc)[2][2][4][2], const Unit& u, int wr, int wc, int fr, int fq) const {
        const int row0 = u.pm * BM + wr * 64 + fr, col0 = u.pn * BM + wc * 32 + 8 * fq; const float* gp = gate + ((u.pm * BM) >> 12) * 12288 + col0;
        f32x4 gv[2][2];
#pragma unroll
        for (int bj = 0; bj < 2; ++bj) { gv[bj][0] = *(const f32x4*)(gp + bj * HALF); gv[bj][1] = *(const f32x4*)(gp + bj * HALF + 4); }
#pragma unroll
        for (int ai = 0; ai < 2; ++ai) {
            f32x4 xv[4][2][2];
#pragma unroll
            for (int m = 0; m < 4; ++m) { const size_t off = (size_t)(row0 + ai * HALF + m * 16) * ldc + col0;
#pragma unroll
                for (int bj = 0; bj < 2; ++bj) { xv[m][bj][0] = __builtin_nontemporal_load((const f32x4*)(base + off + bj * HALF)); xv[m][bj][1] = __builtin_nontemporal_load((const f32x4*)(base + off + bj * HALF + 4)); } }
#pragma unroll
            for (int m = 0; m < 4; ++m) { const size_t off = (size_t)(row0 + ai * HALF + m * 16) * ldc + col0;
#pragma unroll
                for (int bj = 0; bj < 2; ++bj) { const f32x4 v0 = xv[m][bj][0] + gv[bj][0] * acc[ai][bj][m][0], v1 = xv[m][bj][1] + gv[bj][1] * acc[ai][bj][m][1];
                    u32x4 w; w.x = cvt_pk_bf16(v0[0], v0[1]); w.y = cvt_pk_bf16(v0[2], v0[3]); w.z = cvt_pk_bf16(v1[0], v1[1]); w.w = cvt_pk_bf16(v1[2], v1[3]);
                    *(u32x4*)(O + off + bj * HALF) = w; } }
            asm volatile("" ::: "memory");
        }
    }
};
struct EpiResInB {
    static constexpr bool PERM = true, AFTER_DRAIN = false;
    const bf16_t* base; const float* gate; float* O; int ldc;
    __device__ __forceinline__ void operator()(const f32x4 (&acc)[2][2][4][2], const Unit& u, int wr, int wc, int fr, int fq) const {
        const int row0 = u.pm * BM + wr * 64 + fr, col0 = u.pn * BM + wc * 32 + 8 * fq; const float* gp = gate + ((u.pm * BM) >> 12) * 12288 + col0;
        f32x4 gv[2][2];
#pragma unroll
        for (int bj = 0; bj < 2; ++bj) { gv[bj][0] = *(const f32x4*)(gp + bj * HALF); gv[bj][1] = *(const f32x4*)(gp + bj * HALF + 4); }
#pragma unroll
        for (int ai = 0; ai < 2; ++ai) {
            u32x4 xw[4][2];
#pragma unroll
            for (int m = 0; m < 4; ++m)
#pragma unroll
                for (int bj = 0; bj < 2; ++bj) xw[m][bj] = __builtin_nontemporal_load((const u32x4*)(base + (size_t)(row0 + ai * HALF + m * 16) * ldc + col0 + bj * HALF));
#pragma unroll
            for (int m = 0; m < 4; ++m) { const size_t off = (size_t)(row0 + ai * HALF + m * 16) * ldc + col0;
#pragma unroll
                for (int bj = 0; bj < 2; ++bj) { const u32x4 q = xw[m][bj];
                    const f32x4 x0 = {__builtin_bit_cast(float, q.x << 16), __builtin_bit_cast(float, q.x & 0xffff0000u), __builtin_bit_cast(float, q.y << 16), __builtin_bit_cast(float, q.y & 0xffff0000u)};
                    const f32x4 x1 = {__builtin_bit_cast(float, q.z << 16), __builtin_bit_cast(float, q.z & 0xffff0000u), __builtin_bit_cast(float, q.w << 16), __builtin_bit_cast(float, q.w & 0xffff0000u)};
                    __builtin_nontemporal_store(x0 + gv[bj][0] * acc[ai][bj][m][0], (f32x4*)(O + off + bj * HALF)); __builtin_nontemporal_store(x1 + gv[bj][1] * acc[ai][bj][m][1], (f32x4*)(O + off + bj * HALF + 4)); } }
            asm volatile("" ::: "memory");
        }
    }
};
}

#define LAS __attribute__((address_space(3)))
typedef unsigned short bf16_t;
typedef float f32x4 __attribute__((ext_vector_type(4)));
typedef unsigned u32x4 __attribute__((ext_vector_type(4)));
typedef unsigned u32x2 __attribute__((ext_vector_type(2)));

constexpr int BATCH = 2, SEQ = 4096, DM = 2048, NTOK = BATCH * SEQ;
constexpr int NH = 8, HD = 64, VD = 128, NG = 64, DFF = 5632, NQKU = 3072;
constexpr float EPS = 1e-6f, LOG2E = 1.4426950408889634f, C2 = 0.125f * LOG2E;
constexpr int LDS_BYTES = 147456;
constexpr int NTHREADS = 512, NWAVES = 8;

constexpr size_t MiB = (size_t)1 << 20;
constexpr size_t WS_CTL = 0, WS_MOD = 1 * MiB, WS_ZERO_BYTES = 2 * MiB;
constexpr size_t WS_WUP = 2 * MiB, WS_WDN = 46 * MiB, WS_X1 = 68 * MiB, WS_HB = 132 * MiB, WS_APRE = 164 * MiB;
constexpr size_t WS_WIN = 164 * MiB, WS_WGLU = 180 * MiB, WS_WOUT = 358 * MiB  , WS_QB = 190 * MiB, WS_KB = 206 * MiB, WS_VT = 222 * MiB;
constexpr size_t WS_UX = 238 * MiB, WS_MIX = 262 * MiB, WS_YG = 294 * MiB, WS_SBUF = 310 * MiB, WS_AMAT = 326 * MiB, WS_WMAT = 340 * MiB, WS_SIDEA = 348 * MiB, WS_SIDEB = 352 * MiB, WS_END = 366 * MiB;
constexpr size_t WS_SIDE = 64 * 1024;

#define GRID_SYNC_CG() do { asm volatile("s_waitcnt vmcnt(0) lgkmcnt(0)" ::: "memory"); grid.sync(); \
    if (__builtin_amdgcn_readfirstlane((int)(threadIdx.x >> 6)) == 0) { __builtin_amdgcn_fence(__ATOMIC_ACQUIRE, "agent"); asm volatile("s_waitcnt vmcnt(0)" ::: "memory"); } __syncthreads(); } while (0)
#define GRID_SYNC() do { xcd_barrier(xbar); } while (0)
#define XCD_SYNC() do { asm volatile("s_waitcnt vmcnt(0) lgkmcnt(0)" ::: "memory"); __syncthreads(); \
    if (threadIdx.x == 0) { const unsigned old_ = __hip_atomic_fetch_add(ctl + 64 * (20 + vx), 1u, __ATOMIC_RELAXED, __HIP_MEMORY_SCOPE_AGENT), gen_ = old_ / (unsigned)nb; \
        if (old_ + 1u == (gen_ + 1u) * (unsigned)nb) __hip_atomic_fetch_add(ctl + 64 * (28 + vx), 1u, __ATOMIC_RELAXED, __HIP_MEMORY_SCOPE_AGENT); \
        else while (__hip_atomic_load(ctl + 64 * (28 + vx), __ATOMIC_RELAXED, __HIP_MEMORY_SCOPE_AGENT) == gen_) __builtin_amdgcn_s_sleep(1); \
        __builtin_amdgcn_fence(__ATOMIC_ACQUIRE, "agent"); asm volatile("s_waitcnt vmcnt(0)" ::: "memory"); } \
    __syncthreads(); } while (0)

#define XB_TMO      128
#define XB_XCNT(j)  (256  + 64 * (j))
#define XB_XSUB(j)  (1280 + 64 * (j))
#define XB_XGEN(j)  (2304 + 64 * (j))
#define XB_TOP      3328
#define XB_TOPGEN   3392
#define XCD_BAR_WORDS 3456
#define XB_SPIN_CAP (1u << 18)

__device__ __forceinline__ unsigned xb_ld(unsigned* p)              { return __hip_atomic_load(p, __ATOMIC_RELAXED, __HIP_MEMORY_SCOPE_AGENT); }
__device__ __forceinline__ unsigned xb_add(unsigned* p, unsigned v) { return __hip_atomic_fetch_add(p, v, __ATOMIC_RELAXED, __HIP_MEMORY_SCOPE_AGENT); }
__device__ __forceinline__ unsigned xb_xcc_id() { return (unsigned)__builtin_amdgcn_s_getreg((3 << 11) | 20) & 0xFu; }
#define XB_SPIN(cond, bar) do { unsigned _sp = 0; while (cond) { __builtin_amdgcn_s_sleep(1); \
    if ((++_sp & 255u) == 0u) { if (xb_ld(&(bar)[XB_TMO])) break; if (_sp > XB_SPIN_CAP) { atomicAdd(&(bar)[XB_TMO], 1u); break; } } } } while (0)

struct XcdBarrier {
    unsigned* bar; unsigned x;
    volatile LAS unsigned* st;
};

__device__ __forceinline__ XcdBarrier xcd_barrier_post(unsigned* bar, volatile LAS unsigned* st) {
    XcdBarrier b; b.bar = bar; b.x = xb_xcc_id(); b.st = st;
    if (threadIdx.x == 0) (void)xb_add(&bar[XB_XCNT(b.x)], 1u);
    return b;
}
__device__ __forceinline__ void xcd_barrier_complete(unsigned* bar, unsigned x, unsigned& nloc, unsigned& nx) {
    const unsigned G = gridDim.x * gridDim.y * gridDim.z;
    unsigned sum, cnt, mine, sp = 0u;
    for (;;) {
        sum = 0u; cnt = 0u; mine = 0u;
#pragma unroll
        for (unsigned j = 0; j < 16; ++j) { const unsigned c = xb_ld(&bar[XB_XCNT(j)]); sum += c; cnt += (c > 0u) ? 1u : 0u; mine = (j == x) ? c : mine; }
        if (sum == G) break;
        __builtin_amdgcn_s_sleep(1);
        if ((++sp & 255u) == 0u) { if (xb_ld(&bar[XB_TMO])) break; if (sp > XB_SPIN_CAP) { atomicAdd(&bar[XB_TMO], 1u); break; } }
    }
    nloc = mine > 0u ? mine : 1u; nx = cnt > 0u ? cnt : 1u;
}

__device__ __forceinline__ void xcd_barrier(const XcdBarrier& b) {
    asm volatile("s_waitcnt vmcnt(0)" ::: "memory");
    __syncthreads();
    if (threadIdx.x == 0) {
        unsigned* bar = b.bar;
        __builtin_amdgcn_s_waitcnt(0);
        unsigned nloc = b.st[0], nx = b.st[1];
        if (nloc == 0u) { xcd_barrier_complete(bar, b.x, nloc, nx); b.st[0] = nloc; b.st[1] = nx; }
        const unsigned old = xb_add(&bar[XB_XSUB(b.x)], 1u);
        const unsigned gen = old / nloc;
        if (old + 1u == (gen + 1u) * nloc) {
            __builtin_amdgcn_fence(__ATOMIC_RELEASE, "agent");
            asm volatile("s_waitcnt vmcnt(0)" ::: "memory");
            const unsigned og = xb_add(&bar[XB_TOP], 1u);
            const unsigned tg = og / nx;
            if (og + 1u == (tg + 1u) * nx) xb_add(&bar[XB_TOPGEN], 1u);
            else XB_SPIN(xb_ld(&bar[XB_TOPGEN]) == tg, bar);
            __builtin_amdgcn_fence(__ATOMIC_ACQUIRE, "agent");
            xb_add(&bar[XB_XGEN(b.x)], 1u);
            asm volatile("s_waitcnt vmcnt(0)" ::: "memory");
        } else {
            XB_SPIN(xb_ld(&bar[XB_XGEN(b.x)]) == gen, bar);
            __builtin_amdgcn_fence(__ATOMIC_ACQUIRE, "agent");
            asm volatile("s_waitcnt vmcnt(0)" ::: "memory");
        }
    }
    __syncthreads();
}

struct Params { const float* in[29]; float* out; unsigned char* ws; };

enum { I_X = 0, I_C, I_WADA, I_BADA, I_N1G, I_N2G, I_WIN, I_QG, I_KG, I_LQ1, I_LK1, I_LQ2, I_LK2, I_SUBG, I_ARE, I_AIM, I_LOGDT, I_BRE, I_BIM, I_CRE, I_CIM, I_SD,
       I_WGLU, I_BGLU, I_WOUT, I_WUP, I_CONVW, I_CONVB, I_WDN };

__device__ __forceinline__ int opaque_tid() { int t = threadIdx.x; asm volatile("" : "+v"(t)); return t; }
__device__ __forceinline__ float wave_sum(float v) {
#pragma unroll
    for (int o = 1; o < 64; o <<= 1) v += __shfl_xor(v, o);
    return v;
}
__device__ __forceinline__ unsigned f2bf(float f) { unsigned u = __builtin_bit_cast(unsigned, f); return (u + 0x7fffu + ((u >> 16) & 1u)) >> 16; }
__device__ __forceinline__ unsigned pk2(float lo, float hi) { return f2bf(lo) | (f2bf(hi) << 16); }
__device__ __forceinline__ float bf2f(unsigned short h) { return __builtin_bit_cast(float, (unsigned)h << 16); }
__device__ __forceinline__ float bflo(unsigned w) { return __builtin_bit_cast(float, w << 16); }
__device__ __forceinline__ float bfhi(unsigned w) { return __builtin_bit_cast(float, w & 0xffff0000u); }
__device__ __forceinline__ float gelu_tanh(float x) {
    const float u = 0.7978845608028654f * (x + 0.044715f * x * x * x);
    return x * __builtin_amdgcn_rcpf(1.0f + __builtin_amdgcn_exp2f(-2.0f * LOG2E * u));
}
__device__ __forceinline__ float sigmoidf_(float z) { return 1.0f * __builtin_amdgcn_rcpf(1.0f + __builtin_amdgcn_exp2f(-LOG2E * z)); }

__device__ __forceinline__ void transpose_tile(const float* __restrict__ W, int N, bf16_t* __restrict__ WT, int ldt, int k0, int n0, int drow0, LAS float* tile, int tid, int drow1 = -1) {
#pragma unroll
    for (int ps = 0; ps < 2; ++ps) {
        const int kk = ps * 32 + (tid >> 4), nn = (tid & 15) * 4;
        const f32x4 v = *(const f32x4*)(W + (size_t)(k0 + kk) * N + n0 + nn);
        tile[kk * 65 + nn + 0] = v.x; tile[kk * 65 + nn + 1] = v.y; tile[kk * 65 + nn + 2] = v.z; tile[kk * 65 + nn + 3] = v.w;
    }
    __syncthreads();
    const int n = tid >> 3, kc = tid & 7;
    u32x4 o;
    o.x = pk2(tile[(8 * kc + 0) * 65 + n], tile[(8 * kc + 1) * 65 + n]);
    o.y = pk2(tile[(8 * kc + 2) * 65 + n], tile[(8 * kc + 3) * 65 + n]);
    o.z = pk2(tile[(8 * kc + 4) * 65 + n], tile[(8 * kc + 5) * 65 + n]);
    o.w = pk2(tile[(8 * kc + 6) * 65 + n], tile[(8 * kc + 7) * 65 + n]);
    const int drow = (drow1 >= 0 && n >= 32) ? drow1 + (n - 32) : drow0 + n;
    *(u32x4*)(WT + (size_t)drow * ldt + k0 + 8 * kc) = o;
    __syncthreads();
}


__device__ __forceinline__ void transpose_tile_w(const float* __restrict__ W, int N, bf16_t* __restrict__ WT, int ldt, int k0, int n0, int drow0, int drow1, LAS float* wt, int lane) {
    const int rr = lane >> 4, c4 = (lane & 15) * 4;
#pragma unroll
    for (int hf = 0; hf < 2; ++hf) {
        f32x4 v[8];
#pragma unroll
        for (int j = 0; j < 8; ++j) v[j] = __builtin_nontemporal_load((const f32x4*)(W + (size_t)(k0 + (hf * 8 + j) * 4 + rr) * N + n0 + c4));
#pragma unroll
        for (int j = 0; j < 8; ++j) { LAS float* p = wt + ((hf * 8 + j) * 4 + rr) * 65 + c4; p[0] = v[j].x; p[1] = v[j].y; p[2] = v[j].z; p[3] = v[j].w; }
    }
    asm volatile("s_waitcnt lgkmcnt(0)" ::: "memory");
#pragma unroll
    for (int o = 0; o < 8; ++o) {
        const int idx = o * 64 + lane, n = idx >> 3, kc = idx & 7; const LAS float* p = wt + (8 * kc) * 65 + n;
        u32x4 w; w.x = pk2(p[0], p[65]); w.y = pk2(p[2 * 65], p[3 * 65]); w.z = pk2(p[4 * 65], p[5 * 65]); w.w = pk2(p[6 * 65], p[7 * 65]);
        const int drow = (drow1 >= 0 && n >= 32) ? drow1 + (n - 32) : drow0 + n;
        *(u32x4*)(WT + (size_t)drow * ldt + k0 + 8 * kc) = w;
    }
    asm volatile("s_waitcnt lgkmcnt(0)" ::: "memory");
}
constexpr int CT_WIN = 32 * 64, CT_GLU = 16 * 16, CT_OUT = 32 * 32, CT_UP = 32 * 176, CT_DN = 88 * 32;
__device__ __forceinline__ void convert_tile_w(const Params& P, int which, int r, LAS float* wt, int lane) {
    unsigned char* ws = P.ws;
    if (which == 0) { const int kb = r / 64, n0 = (r % 64) * 64;
        if (n0 >= 2048 && n0 < 3072) { transpose_tile_w(P.in[I_WIN], 4096, (bf16_t*)(ws + WS_WIN), 2048, kb * 64, n0, 3072 + (n0 - 2048), -1, wt, lane); return; }
        const int lq = n0 < 2048 ? n0 : 2048 + (n0 - 3072), tb = lq & ~255, wcg = (lq & 255) >> 6;
        transpose_tile_w(P.in[I_WIN], 4096, (bf16_t*)(ws + WS_WIN), 2048, kb * 64, n0, tb + 32 * wcg, tb + 128 + 32 * wcg, wt, lane); return; }
    if (which == 1) { transpose_tile_w(P.in[I_WGLU], 1024, (bf16_t*)(ws + WS_WGLU), 1024, (r / 16) * 64, (r % 16) * 64, (r % 16) * 64, -1, wt, lane); return; }
    if (which == 2) { transpose_tile_w(P.in[I_WOUT], 2048, (bf16_t*)(ws + WS_WOUT), 2048, (r / 32) * 64, (r % 32) * 64, (r % 32) * 64, -1, wt, lane); return; }
    if (which == 3) { const int n0 = (r % 176) * 64, isg = n0 >= DFF, f0 = n0 - isg * DFF;
        transpose_tile_w(P.in[I_WUP], 11264, (bf16_t*)(ws + WS_WUP), 2048, (r / 176) * 64, n0, (f0 >> 7) * 256 + isg * 128 + (f0 & 127), -1, wt, lane); return; }
    transpose_tile_w(P.in[I_WDN], 2048, (bf16_t*)(ws + WS_WDN), 5632, (r / 32) * 64, (r % 32) * 64, (r % 32) * 64, -1, wt, lane);
}

__device__ __forceinline__ void gemv_job(const Params& P, int job, LAS float* red, int tid) {
    const int c4 = tid & 15, rsub = tid >> 4;
    const float* cvec = P.in[I_C];
    const f32x4* W4 = (const f32x4*)P.in[I_WADA] + job * 16 + c4;
    f32x4 a0 = {0.f, 0.f, 0.f, 0.f}, a1 = {0.f, 0.f, 0.f, 0.f};
#pragma unroll 8
    for (int i = 0; i < 64; ++i) {
        const int k = i * 32 + rsub;
        const f32x4 w = __builtin_nontemporal_load(W4 + (size_t)k * 3072);
        const float c0 = cvec[k], c1 = cvec[2048 + k];
        const float s0 = c0 * sigmoidf_(c0), s1 = c1 * sigmoidf_(c1);
        a0 += w * s0; a1 += w * s1;
    }
    LAS f32x4* red4 = (LAS f32x4*)red;
    red4[(rsub * 2 + 0) * 16 + c4] = a0; red4[(rsub * 2 + 1) * 16 + c4] = a1;
    __syncthreads();
    if (tid < 32) {
        const int b = tid >> 4, c = tid & 15;
        f32x4 s = {0.f, 0.f, 0.f, 0.f};
#pragma unroll 8
        for (int r = 0; r < 32; ++r) s += red4[(r * 2 + b) * 16 + c];
        const int col = (job * 16 + c) * 4;
        s += *(const f32x4*)(P.in[I_BADA] + col);
        *(f32x4*)((float*)(P.ws + WS_MOD) + b * 12288 + col) = s;
    }
    __syncthreads();
}

__device__ __forceinline__ void norm_mod_store(const f32x4 (&v)[8], const float* g, const float* shift, const float* scale, bf16_t* orow, int lane) {
    float ss = 0.f;
#pragma unroll
    for (int j = 0; j < 8; ++j) ss += (v[j].x * v[j].x + v[j].y * v[j].y) + (v[j].z * v[j].z + v[j].w * v[j].w);
    ss = wave_sum(ss);
    const float rs = rsqrtf(ss * (1.0f / 2048.0f) + EPS);
#pragma unroll
    for (int j = 0; j < 8; ++j) {
        const int col = 4 * (lane + 64 * j);
        const f32x4 g4 = *(const f32x4*)(g + col), sh = *(const f32x4*)(shift + col), sc = *(const f32x4*)(scale + col);
        const f32x4 h = (v[j] * rs * g4) * (sc + 1.0f) + sh;
        u32x2 o; o.x = pk2(h.x, h.y); o.y = pk2(h.z, h.w);
        *(u32x2*)(orow + col) = o;
    }
}

__device__ __forceinline__ void ssm_abar(const Params& P, int g, int p, float& abr, float& abi, float& cr, float& ci) {
    const float dt = expf(P.in[I_LOGDT][g]);
    const float ar = P.in[I_ARE][g * 64 + p], ai = P.in[I_AIM][g * 64 + p];
    const float mag = expf(dt * ar); abr = mag * cosf(dt * ai); abi = mag * sinf(dt * ai);
    const float den = ar * ar + ai * ai, nr = abr - 1.0f, ni = abi;
    cr = (nr * ar + ni * ai) / den; ci = (ni * ar - nr * ai) / den;
}
__device__ __forceinline__ void ssm_tables_job(const Params& P, int g, LAS float* L, int tid) {
    LAS float* pwr = L;
    LAS float* pwi = L + 17 * 64;
    LAS float* bbr = L + 34 * 64;
    LAS float* bbi = bbr + 1024;
    LAS float* ccr = bbi + 1024;
    LAS float* cci = ccr + 1024;
    LAS float* kk = cci + 1024;
    if (tid < 64) {
        const int p = tid; float abr, abi, cr, ci; ssm_abar(P, g, p, abr, abi, cr, ci);
        float xr = 1.f, xi = 0.f;
        for (int n = 0; n <= 16; ++n) { pwr[n * 64 + p] = xr; pwi[n * 64 + p] = xi; const float nr = xr * abr - xi * abi, ni = xr * abi + xi * abr; xr = nr; xi = ni; }
        for (int c = 0; c < 16; ++c) { const float br = P.in[I_BRE][(g * 64 + p) * 16 + c], bi = P.in[I_BIM][(g * 64 + p) * 16 + c]; bbr[p * 16 + c] = cr * br - ci * bi; bbi[p * 16 + c] = cr * bi + ci * br; }
    }
    for (int i = tid; i < 1024; i += NTHREADS) { ccr[i] = P.in[I_CRE][g * 1024 + i]; cci[i] = P.in[I_CIM][g * 1024 + i]; }
    __syncthreads();
    {
        const int pair = tid & 255, c = pair >> 4, c2 = pair & 15, th = tid >> 8;
        float acc[8];
#pragma unroll
        for (int j = 0; j < 8; ++j) acc[j] = 0.f;
        for (int p = 0; p < 64; ++p) {
            const float cr_ = ccr[c * 64 + p], ci_ = cci[c * 64 + p], br = bbr[p * 16 + c2], bi = bbi[p * 16 + c2];
            const float mr = cr_ * br - ci_ * bi, mi = cr_ * bi + ci_ * br;
#pragma unroll
            for (int j = 0; j < 8; ++j) { const int tau = th * 8 + j; acc[j] += mr * pwr[tau * 64 + p] - mi * pwi[tau * 64 + p]; }
        }
#pragma unroll
        for (int j = 0; j < 8; ++j) kk[(th * 8 + j) * 256 + c * 16 + c2] = acc[j];
    }
    __syncthreads();
    bf16_t* AM = (bf16_t*)(P.ws + WS_AMAT) + (size_t)g * 256 * 384;
    for (int ch = tid; ch < 256 * 48; ch += NTHREADS) {
        const int col = ch / 48, k0 = (ch % 48) * 8, t = col >> 4, c = col & 15; float v[8];
        if (k0 < 256) { const int sidx = k0 >> 4, c2 = k0 & 15;
#pragma unroll
            for (int e = 0; e < 8; ++e) v[e] = (sidx <= t) ? kk[(t - sidx) * 256 + c * 16 + c2 + e] : 0.f;
        } else if (k0 < 320) { const int p0 = k0 - 256;
#pragma unroll
            for (int e = 0; e < 8; ++e) v[e] = ccr[c * 64 + p0 + e] * pwr[(t + 1) * 64 + p0 + e] - cci[c * 64 + p0 + e] * pwi[(t + 1) * 64 + p0 + e];
        } else { const int p0 = k0 - 320;
#pragma unroll
            for (int e = 0; e < 8; ++e) v[e] = -(ccr[c * 64 + p0 + e] * pwi[(t + 1) * 64 + p0 + e] + cci[c * 64 + p0 + e] * pwr[(t + 1) * 64 + p0 + e]);
        }
        u32x4 o; o.x = pk2(v[0], v[1]); o.y = pk2(v[2], v[3]); o.z = pk2(v[4], v[5]); o.w = pk2(v[6], v[7]);
        *(u32x4*)(AM + (size_t)col * 384 + k0) = o;
    }
    bf16_t* WM = (bf16_t*)(P.ws + WS_WMAT) + (size_t)g * 256 * 256;
    for (int ch = tid; ch < 256 * 32; ch += NTHREADS) {
        const int row = ch >> 5, k0 = (ch & 31) * 8, sidx = k0 >> 4, c2 = k0 & 15; float v[8];
#pragma unroll
        for (int e = 0; e < 8; ++e) v[e] = 0.f;
        if (row < 128) { const int p = row & 63; const float wr_ = pwr[(15 - sidx) * 64 + p], wi_ = pwi[(15 - sidx) * 64 + p];
#pragma unroll
            for (int e = 0; e < 8; ++e) { const float br = bbr[p * 16 + c2 + e], bi = bbi[p * 16 + c2 + e]; v[e] = (row < 64) ? (wr_ * br - wi_ * bi) : (wr_ * bi + wi_ * br); } }
        u32x4 o; o.x = pk2(v[0], v[1]); o.y = pk2(v[2], v[3]); o.z = pk2(v[4], v[5]); o.w = pk2(v[6], v[7]);
        *(u32x4*)(WM + (size_t)row * 256 + k0) = o;
    }
    __syncthreads();
}
__device__ __forceinline__ void ssm_carry_job(const Params& P, int g, int b, LAS float* L, int tid) {
    const int p = tid & 63, seg = tid >> 6;
    float abr, abi, cr, ci; ssm_abar(P, g, p, abr, abi, cr, ci);
    float a16r = abr, a16i = abi;
#pragma unroll
    for (int i = 0; i < 4; ++i) { const float nr = a16r * a16r - a16i * a16i, ni = 2.f * a16r * a16i; a16r = nr; a16i = ni; }
    float a512r = a16r, a512i = a16i;
#pragma unroll
    for (int i = 0; i < 5; ++i) { const float nr = a512r * a512r - a512i * a512i, ni = 2.f * a512r * a512i; a512r = nr; a512i = ni; }
    const float* S = (const float*)(P.ws + WS_SBUF) + ((size_t)g * 512 + b * 256 + seg * 32) * 128 + p;
    float xr = 0.f, xi = 0.f;
#pragma unroll 8
    for (int jj = 0; jj < 32; ++jj) { const float sr = S[jj * 128], si = S[jj * 128 + 64]; const float nr = a16r * xr - a16i * xi + sr, ni = a16r * xi + a16i * xr + si; xr = nr; xi = ni; }
    L[seg * 128 + p] = xr; L[seg * 128 + 64 + p] = xi;
    __syncthreads();
    float c0r = 0.f, c0i = 0.f;
    for (int q = 0; q < seg; ++q) { const float er = L[q * 128 + p], ei = L[q * 128 + 64 + p]; const float nr = a512r * c0r - a512i * c0i + er, ni = a512r * c0i + a512i * c0r + ei; c0r = nr; c0i = ni; }
    bf16_t* X = (bf16_t*)(P.ws + WS_UX) + ((size_t)g * 512 + b * 256 + seg * 32) * 384 + 256 + p;
    xr = c0r; xi = c0i;
#pragma unroll 8
    for (int jj = 0; jj < 32; ++jj) {
        X[(size_t)jj * 384] = (bf16_t)f2bf(xr); X[(size_t)jj * 384 + 64] = (bf16_t)f2bf(xi);
        const float sr = S[jj * 128], si = S[jj * 128 + 64]; const float nr = a16r * xr - a16i * xi + sr, ni = a16r * xi + a16i * xr + si; xr = nr; xi = ni;
    }
    __syncthreads();
}

typedef float f32x16 __attribute__((ext_vector_type(16)));
typedef short bf16x8v __attribute__((ext_vector_type(8)));
typedef short s16x4v __attribute__((ext_vector_type(4)));
typedef float f32x2v __attribute__((ext_vector_type(2)));
typedef __bf16 bf16x2v __attribute__((ext_vector_type(2)));
__device__ __forceinline__ unsigned cvtpk(float lo, float hi) { f32x2v v = {lo, hi}; bf16x2v b = __builtin_convertvector(v, bf16x2v); return __builtin_bit_cast(unsigned, b); }
constexpr int AT_KP = 144, AT_VP = 144, AT_K1 = 0, AT_K2 = 64 * AT_KP, AT_V = 2 * 64 * AT_KP, AT_STAGE = AT_V + 128 * AT_VP;

__device__ __forceinline__ void attn_unit(const Params& P, LAS unsigned char* lds, int b, int h, int qb, float lam, float wnd2b, int tid) {
    const int lane = tid & 63, wave = __builtin_amdgcn_readfirstlane(tid >> 6), sm = wave >> 2, rb = wave & 3, l31 = lane & 31, kg = lane >> 5;
    const bf16_t* QB = (const bf16_t*)(P.ws + WS_QB); const bf16_t* KB = (const bf16_t*)(P.ws + WS_KB); const bf16_t* VT = (const bf16_t*)(P.ws + WS_VT);
    bf16_t* MIX = (bf16_t*)(P.ws + WS_MIX);
    const int q0 = qb * 128; const size_t tokb = (size_t)b * SEQ;
    const int qw0 = q0 + 32 * rb, qpos = qw0 + l31;
    bf16x8v qf[4];
    { const bf16_t* qp = QB + (tokb + qpos) * 1024 + h * 128 + sm * 64 + 8 * kg;
#pragma unroll
      for (int ks = 0; ks < 4; ++ks) qf[ks] = *(const bf16x8v*)(qp + 16 * ks); }
    const float sl2 = exp2f(-(float)(h + 1)) * LOG2E;
    float l = 0.f; const float bref = 0.5f * (wnd2b - 64.0f);
    f32x16 o[4];
#pragma unroll
    for (int vb = 0; vb < 4; ++vb)
#pragma unroll
        for (int r = 0; r < 16; ++r) o[vb][r] = 0.f;
    const int NT = 2 * (qb + 1);
    int t0 = (int)floorf(((float)(q0 - 63) - wnd2b / sl2) * (1.0f / 64.0f)) + 1; t0 = t0 < 0 ? 0 : t0;
    const int krow = tid >> 3, kch = tid & 7;
    const bf16_t* kg1 = KB + (tokb + krow) * 1024 + h * 128 + kch * 8;
    const bf16_t* vg0 = VT + (size_t)(h * 128 + krow) * NTOK + tokb + kch * 8;
    const bf16_t* vg1 = vg0 + (size_t)64 * NTOK;
    const int kofs = krow * AT_KP + kch * 16, vofs0 = AT_V + krow * AT_VP + ((kch >> 1) * 16 + (kch & 1) * 4) * 2, vofs1 = vofs0 + 64 * AT_VP;
    u32x4 rk1, rk2, rv0, rv1;
#define AT_LOAD(t) do { const bf16_t* kp_ = kg1 + (size_t)(t) * 64 * 1024; rk1 = *(const u32x4*)kp_; rk2 = *(const u32x4*)(kp_ + 64); rv0 = *(const u32x4*)(vg0 + (t) * 64); rv1 = *(const u32x4*)(vg1 + (t) * 64); } while (0)
#define AT_STORE(base) do { *(LAS u32x4*)((base) + AT_K1 + kofs) = rk1; *(LAS u32x4*)((base) + AT_K2 + kofs) = rk2; \
        *(LAS u32x2*)((base) + vofs0) = (u32x2){rv0.x, rv0.y}; *(LAS u32x2*)((base) + vofs0 + 16) = (u32x2){rv0.z, rv0.w}; \
        *(LAS u32x2*)((base) + vofs1) = (u32x2){rv1.x, rv1.y}; *(LAS u32x2*)((base) + vofs1 + 16) = (u32x2){rv1.z, rv1.w}; } while (0)
    AT_LOAD(t0); AT_STORE(lds + (t0 & 1) * AT_STAGE); __syncthreads();
    for (int t = t0; t < NT; ++t) {
        LAS unsigned char* cur = lds + (t & 1) * AT_STAGE; LAS unsigned char* nxt = lds + ((t + 1) & 1) * AT_STAGE;
        if (t + 1 < NT) AT_LOAD(t + 1);
        const int kv0 = t * 64;
        if (kv0 <= qw0 + 31) {
            f32x16 p0, p1;
            { const float cbase = sl2 * (float)(kv0 + 4 * kg - qpos) - bref, s32 = 32.f * sl2;
#pragma unroll
              for (int r = 0; r < 16; ++r) { p0[r] = cbase + sl2 * (float)((r & 3) + 8 * (r >> 2)); p1[r] = p0[r] + s32; } }
            const LAS unsigned char* kb = cur + (sm ? AT_K2 : AT_K1) + l31 * AT_KP + kg * 16;
            __builtin_amdgcn_s_setprio(1);
#pragma unroll
            for (int ks = 0; ks < 4; ++ks) {
                const bf16x8v a0 = *(const LAS bf16x8v*)(kb + ks * 32), a1 = *(const LAS bf16x8v*)(kb + 32 * AT_KP + ks * 32);
                p0 = __builtin_amdgcn_mfma_f32_32x32x16_bf16(a0, qf[ks], p0, 0, 0, 0);
                p1 = __builtin_amdgcn_mfma_f32_32x32x16_bf16(a1, qf[ks], p1, 0, 0, 0);
            }
            __builtin_amdgcn_s_setprio(0);
            if (kv0 + 63 > qw0) {
                const int kb0 = kv0 + 4 * kg;
#pragma unroll
                for (int r = 0; r < 16; ++r) { const int kvp = kb0 + (r & 3) + 8 * (r >> 2); if (kvp > qpos) p0[r] = -INFINITY; if (kvp + 32 > qpos) p1[r] = -INFINITY; }
            }
            float ps = 0.f;
#pragma unroll
            for (int r = 0; r < 16; ++r) { p0[r] = __builtin_amdgcn_exp2f(p0[r]); p1[r] = __builtin_amdgcn_exp2f(p1[r]); ps += p0[r] + p1[r]; }
            l += ps;
            bf16x8v pb[4];
            { u32x4 w;
              w.x = cvtpk(p0[0], p0[1]); w.y = cvtpk(p0[2], p0[3]); w.z = cvtpk(p0[4], p0[5]); w.w = cvtpk(p0[6], p0[7]); pb[0] = __builtin_bit_cast(bf16x8v, w);
              w.x = cvtpk(p0[8], p0[9]); w.y = cvtpk(p0[10], p0[11]); w.z = cvtpk(p0[12], p0[13]); w.w = cvtpk(p0[14], p0[15]); pb[1] = __builtin_bit_cast(bf16x8v, w);
              w.x = cvtpk(p1[0], p1[1]); w.y = cvtpk(p1[2], p1[3]); w.z = cvtpk(p1[4], p1[5]); w.w = cvtpk(p1[6], p1[7]); pb[2] = __builtin_bit_cast(bf16x8v, w);
              w.x = cvtpk(p1[8], p1[9]); w.y = cvtpk(p1[10], p1[11]); w.z = cvtpk(p1[12], p1[13]); w.w = cvtpk(p1[14], p1[15]); pb[3] = __builtin_bit_cast(bf16x8v, w); }
            const LAS unsigned char* vbp = cur + AT_V + l31 * AT_VP + kg * 16;
            __builtin_amdgcn_s_setprio(1);
#pragma unroll
            for (int vb = 0; vb < 4; ++vb)
#pragma unroll
                for (int k2 = 0; k2 < 4; ++k2) {
                    const bf16x8v av = *(const LAS bf16x8v*)(vbp + vb * 32 * AT_VP + k2 * 32);
                    o[vb] = __builtin_amdgcn_mfma_f32_32x32x16_bf16(av, pb[k2], o[vb], 0, 0, 0);
                }
            __builtin_amdgcn_s_setprio(0);
        }
        if (t + 1 < NT) AT_STORE(nxt);
        __syncthreads();
    }
#undef AT_LOAD
#undef AT_STORE
    const float inv = 1.0f / (l + __shfl_xor(l, 32));
    LAS float* ob = (LAS float*)lds;
    if (sm == 1) {
#pragma unroll
        for (int vb = 0; vb < 4; ++vb)
#pragma unroll
            for (int r = 0; r < 16; ++r) ob[((rb * 4 + vb) * 16 + r) * 64 + lane] = o[vb][r] * inv;
    }
    __syncthreads();
    if (sm == 0) {
        float ss = 0.f;
#pragma unroll
        for (int vb = 0; vb < 4; ++vb)
#pragma unroll
            for (int r = 0; r < 16; ++r) { const float d = o[vb][r] * inv - lam * ob[((rb * 4 + vb) * 16 + r) * 64 + lane]; o[vb][r] = d; ss += d * d; }
        ss += __shfl_xor(ss, 32);
        const float rn = rsqrtf(ss * (1.0f / 128.0f) + EPS) * 0.8f;
        const float* gs = P.in[I_SUBG];
        bf16_t* mp = MIX + (tokb + qpos) * 2048 + h * 128;
#pragma unroll
        for (int vb = 0; vb < 4; ++vb)
#pragma unroll
            for (int r4 = 0; r4 < 4; ++r4) {
                const int vc = 32 * vb + 8 * r4 + 4 * kg; const f32x4 g4 = *(const f32x4*)(gs + vc);
                u32x2 w; w.x = cvtpk(o[vb][4 * r4 + 0] * rn * g4.x, o[vb][4 * r4 + 1] * rn * g4.y); w.y = cvtpk(o[vb][4 * r4 + 2] * rn * g4.z, o[vb][4 * r4 + 3] * rn * g4.w);
                *(u32x2*)(mp + vc) = w;
            }
    }
    __syncthreads();
}

constexpr int LATE_SPLIT = 288;
#define LATE_W_ITEM(done_, cw_, lo_, hi_) do { \
        constexpr int J_OUT_ = 32 * 32, J_UP_ = 32 * 176, J_LATE_ = J_OUT_ + J_UP_;     \
        const int tid_ = opaque_tid(); \
        if (tid_ == 0) lctl[3] = __hip_atomic_fetch_add(ctl + 64 * (cw_), 1u, __ATOMIC_RELAXED, __HIP_MEMORY_SCOPE_AGENT); \
        __syncthreads(); \
        const int it_ = (lo_) + __builtin_amdgcn_readfirstlane((int)lctl[3]); \
        __syncthreads(); \
        if (it_ >= (hi_) || it_ * 16 >= J_LATE_) { done_ = true; break; } \
        { const int w_ = __builtin_amdgcn_readfirstlane(tid_ >> 6), ln_ = tid_ & 63; \
          for (int q_ = 0; q_ < 2; ++q_) { const int r_ = it_ * 16 + q_ * 8 + w_; if (r_ < J_LATE_) { if (r_ < J_OUT_) convert_tile_w(P, 2, r_, ldsf + w_ * (64 * 65), ln_); else convert_tile_w(P, 3, r_ - J_OUT_, ldsf + w_ * (64 * 65), ln_); } } } \
        __syncthreads(); } while (0)

#define WDN_QUEUE() do { for (;;) { const int tid_ = opaque_tid(); \
        if (tid_ == 0) lctl[3] = __hip_atomic_fetch_add(ctl + 64 * 13, 1u, __ATOMIC_RELAXED, __HIP_MEMORY_SCOPE_AGENT); \
        __syncthreads(); \
        const int it_ = __builtin_amdgcn_readfirstlane((int)lctl[3]); \
        __syncthreads(); \
        if (it_ * 8 >= 88 * 32) break; \
        { const int w_ = __builtin_amdgcn_readfirstlane(tid_ >> 6); convert_tile_w(P, 4, it_ * 8 + w_, ldsf + w_ * (64 * 65), tid_ & 63); } __syncthreads(); } } while (0)

__global__ void __launch_bounds__(NTHREADS, 2) fwd_kernel(Params P) {
    extern __shared__ __attribute__((aligned(16))) unsigned char lds_raw[];
    cg::grid_group grid = cg::this_grid();
    LAS unsigned char* lds = (LAS unsigned char*)lds_raw;
    LAS float* ldsf = (LAS float*)lds_raw;
    const int tid = threadIdx.x, lane = tid & 63, wave = __builtin_amdgcn_readfirstlane(tid >> 6);
    const int G = gridDim.x, bid = blockIdx.x;
    unsigned* ctl = (unsigned*)(P.ws + WS_CTL);
    LAS unsigned* lctl = (LAS unsigned*)(lds_raw + LDS_BYTES - 256);
    if (tid == 0) { lctl[4] = 0u; lctl[5] = 0u; }
    if (bid == 0) {
        u32x4* z = (u32x4*)ctl;
        for (int i = tid; i < 65536 / 16; i += NTHREADS) z[i] = (u32x4){0u, 0u, 0u, 0u};
        asm volatile("s_waitcnt vmcnt(0)" ::: "memory");
    }
    __syncthreads();
    grid.sync();
    XcdBarrier xbar = xcd_barrier_post(ctl + 4096, (volatile LAS unsigned*)(lctl + 4));
    if (tid == 0) { const unsigned x = ((unsigned)__builtin_amdgcn_s_getreg((3 << 11) | 20)) & 7u; lctl[0] = x; lctl[1] = __hip_atomic_fetch_add(ctl + 64 * x, 1u, __ATOMIC_RELAXED, __HIP_MEMORY_SCOPE_AGENT); }
    __syncthreads();
    const int vx = __builtin_amdgcn_readfirstlane((int)lctl[0]), rank = __builtin_amdgcn_readfirstlane((int)lctl[1]);
    unsigned char* ws = P.ws;
    bf16_t* WUP = (bf16_t*)(ws + WS_WUP); bf16_t* WDN = (bf16_t*)(ws + WS_WDN); float* X1 = (float*)(ws + WS_X1); bf16_t* HB = (bf16_t*)(ws + WS_HB);
    bf16_t* APRE = (bf16_t*)(ws + WS_APRE); bf16_t* WIN = (bf16_t*)(ws + WS_WIN); bf16_t* WGLU = (bf16_t*)(ws + WS_WGLU); bf16_t* WOUT = (bf16_t*)(ws + WS_WOUT);
    bf16_t* QB = (bf16_t*)(ws + WS_QB); bf16_t* KB = (bf16_t*)(ws + WS_KB); bf16_t* VT = (bf16_t*)(ws + WS_VT); bf16_t* UX = (bf16_t*)(ws + WS_UX);
    bf16_t* MIX = (bf16_t*)(ws + WS_MIX); bf16_t* YG = (bf16_t*)(ws + WS_YG);
    const float* MOD = (const float*)(ws + WS_MOD);

    {
        const int tid = opaque_tid(), lane = tid & 63, wave = __builtin_amdgcn_readfirstlane(tid >> 6); const int lw = rank * NWAVES + wave, lt = rank * NTHREADS + tid; (void)lane; (void)lw; (void)lt;
        constexpr int J_GEMV = 192, J_T8 = (CT_WIN + CT_GLU) / 8;
        constexpr int J_TOTAL = 64 + J_GEMV + J_T8;
        const bool split = G >= 128;
        for (int k_ = 0; ; ++k_) {
            int job;
            if (!split) job = bid + k_ * G;
            else if (bid < 64) { if (k_ > 0) break; job = bid; }
            else job = 64 + (bid - 64) + k_ * (G - 64);
            if (job >= J_TOTAL) break;
            int r = job;
            if (r < 64) { ssm_tables_job(P, r, ldsf, tid); continue; } r -= 64;
            if (r < J_GEMV) { gemv_job(P, r, ldsf, tid); continue; } r -= J_GEMV;
            const int tl = r * 8 + wave;
            if (tl < CT_WIN) convert_tile_w(P, 0, tl, ldsf + wave * (64 * 65), lane); else convert_tile_w(P, 1, tl - CT_WIN, ldsf + wave * (64 * 65), lane);
        }
    }
    GRID_SYNC();
    const int nb = __builtin_amdgcn_readfirstlane((int)__hip_atomic_load(ctl + 64 * vx, __ATOMIC_RELAXED, __HIP_MEMORY_SCOPE_AGENT));
    const int NLW = nb * NWAVES, row_base = vx * 1024, NLT = nb * NTHREADS;

    { const int tid = opaque_tid(), lane = tid & 63, wave = __builtin_amdgcn_readfirstlane(tid >> 6); const int lw = rank * NWAVES + wave, lt = rank * NTHREADS + tid; (void)lane; (void)lw; (void)lt;
    for (int lr = lw; lr < 1024; lr += NLW) { const int row = row_base + lr;
        const int b = row >> 12;
        const f32x4* xr = (const f32x4*)(P.in[I_X] + (size_t)row * DM);
        f32x4 v[8];
#pragma unroll
        for (int j = 0; j < 8; ++j) v[j] = __builtin_nontemporal_load(xr + lane + 64 * j);
        norm_mod_store(v, P.in[I_N1G], MOD + b * 12288 + 0, MOD + b * 12288 + 2048, HB + (size_t)row * DM, lane);
    }
    }
    XCD_SYNC();
    {
        pg8::Gemm g{HB, WIN, NTOK, NQKU, DM, DM, DM}; pg8::XcdOrder S; S.init(NTOK, NQKU, vx, rank, nb);
        pg8::EpiQKU E{QB, KB, UX, P.in[I_QG], P.in[I_KG], C2, EPS};
        pg8::gemm_phase<pg8::EpiQKU, pg8::XcdOrder, true, true>(lds, g, S, E);
    }
    {
        pg8::Gemm g{WIN + (size_t)3072 * DM, HB, 1024, NTOK, DM, DM, DM}; pg8::VtOrder S; S.init(vx, rank, nb);
        pg8::EpiBf16<0> E{VT, NTOK, nullptr, 0, 0, 1.f};
        pg8::gemm_phase<pg8::EpiBf16<0>, pg8::VtOrder, true, true>(lds, g, S, E);
    }
    GRID_SYNC();
    for (;;) {
        const int tid = opaque_tid();
        if (tid == 0) lctl[2] = __hip_atomic_fetch_add(ctl + 64 * 9, 1u, __ATOMIC_RELAXED, __HIP_MEMORY_SCOPE_AGENT);
        __syncthreads();
        const int u0 = __builtin_amdgcn_readfirstlane((int)lctl[2]);
        __syncthreads();
        if (u0 >= 128) break;
        const int sg = u0 >> 1, sb = u0 & 1;
        { int kS = 256; asm volatile("" : "+s"(kS));
          pg8::Gemm g{UX, (const bf16_t*)(ws + WS_WMAT), 64 * 512, 256, kS, 384, 256}; pg8::OneUnit S{u0, sg}; pg8::EpiS E{(float*)(ws + WS_SBUF)};
          pg8::gemm_phase<pg8::EpiS, pg8::OneUnit, true, true>(lds, g, S, E); }
        asm volatile("s_waitcnt vmcnt(0) lgkmcnt(0)" ::: "memory"); __syncthreads();
        ssm_carry_job(P, sg, sb, ldsf, opaque_tid());
        asm volatile("s_waitcnt vmcnt(0) lgkmcnt(0)" ::: "memory"); __syncthreads();
        { int kY = 384; asm volatile("" : "+s"(kY));
          pg8::Gemm g{UX, (const bf16_t*)(ws + WS_AMAT), 64 * 512, 256, kY, 384, 384}; pg8::OneUnit S{u0, sg}; pg8::EpiY E{UX, P.in[I_SD], YG};
          pg8::gemm_phase<pg8::EpiY, pg8::OneUnit, true, true>(lds, g, S, E); }
        asm volatile("s_waitcnt vmcnt(0) lgkmcnt(0)" ::: "memory"); __syncthreads();
        if (opaque_tid() == 0) {
            __builtin_amdgcn_fence(__ATOMIC_RELEASE, "agent"); asm volatile("s_waitcnt vmcnt(0)" ::: "memory");
            __hip_atomic_fetch_add(ctl + 64 * (16 + sb), 1u, __ATOMIC_RELAXED, __HIP_MEMORY_SCOPE_AGENT); }
    }
    {
        const int tid = opaque_tid(), lane = tid & 63;
        float lam, wnd2b;
        { const float a = wave_sum(P.in[I_LQ1][lane] * P.in[I_LK1][lane]), b2 = wave_sum(P.in[I_LQ2][lane] * P.in[I_LK2][lane]); lam = expf(a) - expf(b2) + 0.2f; }
        { float gq = fabsf(P.in[I_QG][lane]), gk = fabsf(P.in[I_KG][lane]);
#pragma unroll
          for (int o_ = 1; o_ < 64; o_ <<= 1) { gq = fmaxf(gq, __shfl_xor(gq, o_)); gk = fmaxf(gk, __shfl_xor(gk, o_)); }
          wnd2b = 2.0f * (8.0f * gq * gk * LOG2E * 1.02f) + 64.0f; }
        bool late_w_done = false;
        for (;;) {
            if (tid == 0) lctl[2] = __hip_atomic_fetch_add(ctl + 64 * 10, 1u, __ATOMIC_RELAXED, __HIP_MEMORY_SCOPE_AGENT);
            __syncthreads();
            const int u = __builtin_amdgcn_readfirstlane((int)lctl[2]);
            __syncthreads();
            if (u >= BATCH * NH * 32) break;
            attn_unit(P, lds, (u & 15) >> 3, u & 7, 31 - (u >> 4), lam, wnd2b, tid);
            if (!late_w_done) LATE_W_ITEM(late_w_done, 15, 0, LATE_SPLIT);
        }
    }
    for (;;) {
        const int tid = opaque_tid();
        if (tid == 0) lctl[2] = __hip_atomic_fetch_add(ctl + 64 * 14, 1u, __ATOMIC_RELAXED, __HIP_MEMORY_SCOPE_AGENT);
        __syncthreads();
        const int t = __builtin_amdgcn_readfirstlane((int)lctl[2]);
        __syncthreads();
        if (t >= 128) break;
        const int pm = t >> 2, pn = t & 3;
        if (tid == 0) {
            while (__hip_atomic_load(ctl + 64 * (16 + (pm >> 4)), __ATOMIC_RELAXED, __HIP_MEMORY_SCOPE_AGENT) < 64u) __builtin_amdgcn_s_sleep(8);
            __builtin_amdgcn_fence(__ATOMIC_ACQUIRE, "agent"); asm volatile("s_waitcnt vmcnt(0)" ::: "memory"); }
        __syncthreads();
        { pg8::Gemm g{YG, WGLU, NTOK, 1024, 1024, 1024, 1024}; pg8::OneUnit S{pm, pn}; pg8::EpiGlu E{YG, 1024, P.in[I_BGLU], MIX + 1024, 2048};
          pg8::gemm_phase<pg8::EpiGlu, pg8::OneUnit, true, true>(lds, g, S, E); }
        asm volatile("s_waitcnt vmcnt(0) lgkmcnt(0)" ::: "memory"); __syncthreads();
    }
    { bool late_done = false;
      while (!late_done) LATE_W_ITEM(late_done, 18, LATE_SPLIT, 416);
      late_done = false; while (!late_done) LATE_W_ITEM(late_done, 15, 0, LATE_SPLIT); }
    GRID_SYNC();
    {
        pg8::Gemm g{MIX, WOUT, NTOK, DM, DM, DM, DM}; pg8::XcdOrder S; S.init(NTOK, DM, vx, rank, nb);
        pg8::EpiResOutB E{P.in[I_X], MOD + 4096, (bf16_t*)X1, DM};
        pg8::gemm_phase<pg8::EpiResOutB, pg8::XcdOrder, true, true>(lds, g, S, E);
    }
    XCD_SYNC();
    { const int tid = opaque_tid(), lane = tid & 63, wave = __builtin_amdgcn_readfirstlane(tid >> 6); const int lw = rank * NWAVES + wave, lt = rank * NTHREADS + tid; (void)lane; (void)lw; (void)lt;
    for (int lr = lw; lr < 1024; lr += NLW) { const int row = row_base + lr;
        const int b = row >> 12;
        const u32x2* x1r = (const u32x2*)((const bf16_t*)X1 + (size_t)row * DM);
        f32x4 v[8];
#pragma unroll
        for (int j = 0; j < 8; ++j) { const u32x2 q = __builtin_nontemporal_load(x1r + lane + 64 * j); v[j] = (f32x4){bflo(q.x), bfhi(q.x), bflo(q.y), bfhi(q.y)}; }
        norm_mod_store(v, P.in[I_N2G], MOD + b * 12288 + 6144, MOD + b * 12288 + 8192, HB + (size_t)row * DM, lane);
    }
    }
    XCD_SYNC();
    bf16_t* ACT = APRE;
    {
        pg8::Gemm g{HB, WUP, NTOK, 2 * DFF, DM, DM, DM}; pg8::XcdOrder S; S.init(NTOK, 2 * DFF, vx, rank, nb);
        pg8::EpiUpAct E{ACT, (bf16_t*)(ws + WS_SIDEA), (bf16_t*)(ws + WS_SIDEB), P.in[I_CONVW], P.in[I_CONVB], DFF};
        pg8::gemm_phase<pg8::EpiUpAct, pg8::XcdOrder, true, true>(lds, g, S, E);
        WDN_QUEUE();
    }
    GRID_SYNC();
    { const int tid = opaque_tid(); const int lt = rank * NTHREADS + tid;
    for (int lj = lt; lj < 16 * 704; lj += NLT) {
        const int fv = lj % 704, blk = vx * 16 + lj / 704, f0 = fv * 8, t0 = blk * 64;
        const bf16_t* sA = (const bf16_t*)(ws + WS_SIDEA); const bf16_t* sB = (const bf16_t*)(ws + WS_SIDEB) + (size_t)blk * 4 * DFF + f0;
        u32x4 pm2 = {0u, 0u, 0u, 0u}, pm1 = {0u, 0u, 0u, 0u};
        if ((t0 & 4095) != 0) { const bf16_t* p = sA + (size_t)(blk - 1) * 2 * DFF + f0; pm2 = *(const u32x4*)p; pm1 = *(const u32x4*)(p + DFF); }
        const u32x4 qa0 = *(const u32x4*)sB, qg0 = *(const u32x4*)(sB + DFF), qa1 = *(const u32x4*)(sB + 2 * DFF), qg1 = *(const u32x4*)(sB + 3 * DFF);
        float am2[8], am1[8], a0[8], g0[8], a1[8], g1[8], o0[8], o1[8];
#define UNPK(dst, V_) do { dst[0] = bflo(V_.x); dst[1] = bfhi(V_.x); dst[2] = bflo(V_.y); dst[3] = bfhi(V_.y); dst[4] = bflo(V_.z); dst[5] = bfhi(V_.z); dst[6] = bflo(V_.w); dst[7] = bfhi(V_.w); } while (0)
        UNPK(am2, pm2); UNPK(am1, pm1); UNPK(a0, qa0); UNPK(g0, qg0); UNPK(a1, qa1); UNPK(g1, qg1);
#undef UNPK
#pragma unroll
        for (int h = 0; h < 2; ++h) { const f32x4 c0 = *(const f32x4*)(P.in[I_CONVW] + f0 + 4 * h), c1 = *(const f32x4*)(P.in[I_CONVW] + DFF + f0 + 4 * h), c2 = *(const f32x4*)(P.in[I_CONVW] + 2 * DFF + f0 + 4 * h), bb = *(const f32x4*)(P.in[I_CONVB] + f0 + 4 * h);
#pragma unroll
            for (int e4 = 0; e4 < 4; ++e4) { const int e = 4 * h + e4;
                o0[e] = gelu_tanh(c0[e4] * am2[e] + c1[e4] * am1[e] + c2[e4] * a0[e] + bb[e4]) * g0[e];
                o1[e] = gelu_tanh(c0[e4] * am1[e] + c1[e4] * a0[e] + c2[e4] * a1[e] + bb[e4]) * g1[e]; } }
        u32x4 w0, w1; w0.x = pk2(o0[0], o0[1]); w0.y = pk2(o0[2], o0[3]); w0.z = pk2(o0[4], o0[5]); w0.w = pk2(o0[6], o0[7]);
        w1.x = pk2(o1[0], o1[1]); w1.y = pk2(o1[2], o1[3]); w1.z = pk2(o1[4], o1[5]); w1.w = pk2(o1[6], o1[7]);
        *(u32x4*)(ACT + (size_t)t0 * DFF + f0) = w0; *(u32x4*)(ACT + (size_t)(t0 + 1) * DFF + f0) = w1;
    }
    }
    XCD_SYNC();

    {
        pg8::Gemm g{ACT, WDN, NTOK, DM, DFF, DFF, DFF}; pg8::XcdOrder S; S.init(NTOK, DM, vx, rank, nb);
        pg8::EpiResInB E{(const bf16_t*)X1, MOD + 10240, P.out, DM};
        pg8::gemm_phase<pg8::EpiResInB, pg8::XcdOrder, true, true>(lds, g, S, E);
    }
}

extern "C" void kernel_launch(void* const* d_in, const int* in_sizes, int n_in, void* d_out, int out_size, void* d_ws, size_t ws_size, hipStream_t stream) {
    static int grid_blocks = 0;
    if (grid_blocks == 0) {
        if (n_in != 29 || ws_size < WS_END) { fprintf(stderr, "kernel_launch: unexpected n_in %d or ws_size %zu\n", n_in, ws_size); grid_blocks = -1; return; }
        int dev = 0, cus = 0, per_cu = 0;
        hipGetDevice(&dev);
        hipDeviceGetAttribute(&cus, hipDeviceAttributeMultiprocessorCount, dev);
        if (hipFuncSetAttribute((const void*)fwd_kernel, hipFuncAttributeMaxDynamicSharedMemorySize, LDS_BYTES) != hipSuccess) fprintf(stderr, "hipFuncSetAttribute failed\n");
        if (hipOccupancyMaxActiveBlocksPerMultiprocessor(&per_cu, (const void*)fwd_kernel, NTHREADS, LDS_BYTES) != hipSuccess || per_cu < 1) { fprintf(stderr, "occupancy query: %d\n", per_cu); per_cu = 1; }
        (void)hipGetLastError();
        grid_blocks = cus;
    }
    if (grid_blocks < 0) return;
    Params p{};
    for (int i = 0; i < 29; ++i) p.in[i] = (const float*)d_in[i];
    p.out = (float*)d_out; p.ws = (unsigned char*)d_ws;
    void* args[] = {&p};
    hipError_t e = hipLaunchCooperativeKernel((const void*)fwd_kernel, dim3(grid_blocks), dim3(NTHREADS), args, LDS_BYTES, stream);
    if (e != hipSuccess) fprintf(stderr, "cooperative launch failed: %s (grid %d)\n", hipGetErrorString(e), grid_blocks);
}
```

```cpp
#include <hip/hip_runtime.h>
#include <hip/hip_cooperative_groups.h>
#include <cstdio>
#include <cstdint>
namespace cg = cooperative_groups;
namespace pg8 {
#define PG8_LAS __attribute__((address_space(3)))
typedef unsigned short bf16_t;
typedef short bf16x8 __attribute__((ext_vector_type(8)));
typedef float f32x4 __attribute__((ext_vector_type(4)));
typedef unsigned u32x4 __attribute__((ext_vector_type(4)));
constexpr int BM = 256, BK = 64, HALF = 128, HTB = HALF * BK * 2  , STAGE_BYTES = 8 * HTB, NXCD = 8, WGM = 8;

__host__ __device__ __forceinline__ int lds_byte(int r, int c) { const int st = (r >> 4) * 2 + (c >> 5), rr = r & 15, cc = c & 31, ob = rr * 64 + cc * 2; return st * 1024 + (ob ^ (((ob >> 9) & 1) << 5)); }
__host__ __device__ __forceinline__ void stage_rc(int b, int& R, int& C) { const int st = b / 1024, sb = b % 1024, swz = sb ^ (((sb >> 9) & 1) << 5); R = (st >> 1) * 16 + swz / 64; C = (st & 1) * 32 + (swz % 64) / 2; }
__host__ __device__ __forceinline__ int perm32(int rho) { const int n = rho >> 4, i = rho & 15; return 8 * (i >> 2) + 4 * n + (i & 3); }

struct Unit { int pm, pn; };
struct Gemm { const bf16_t* A; const bf16_t* Bt; int M, N, K, lda, ldb; };

struct StaticOrder {
    int nM, nN, nwg, G, c;
    __host__ __device__ void init(int M, int N, int G_, int c_) { nM = M / BM; nN = N / BM; nwg = nM * nN; G = G_; c = c_; }
    __host__ __device__ bool next(int i, Unit& u) const {
        const long L = (long)i * G + c; if (L >= nwg) return false;
        int wgid = (int)L; { const int q = nwg / NXCD, r = nwg % NXCD, xcd = wgid % NXCD, off = wgid / NXCD; wgid = (xcd < r ? xcd * (q + 1) : r * (q + 1) + (xcd - r) * q) + off; }
        const int nig = WGM * nN, gid = wgid / nig, fm = gid * WGM, gsz = (nM - fm) < WGM ? (nM - fm) : WGM;
        u.pm = fm + ((wgid % nig) % gsz); u.pn = (wgid % nig) / gsz; return true;
    }
    __device__ __forceinline__ void a_ready(const Unit&) const {}
    __device__ __forceinline__ void done(const Unit&) const {}
};

__device__ __forceinline__ unsigned cvt_pk_bf16(float lo, float hi) { unsigned r; asm volatile("v_cvt_pk_bf16_f32 %0, %1, %2" : "=v"(r) : "v"(lo), "v"(hi)); return r; }
typedef float f32x2 __attribute__((ext_vector_type(2)));
__device__ __forceinline__ f32x2 gelu_pk(f32x2 v) {
    const f32x2 av = __builtin_elementwise_abs(v), d = av * 0.2316418882f + 1.0f;
    f32x2 t; t.x = __builtin_amdgcn_rcpf(d.x); t.y = __builtin_amdgcn_rcpf(d.y);
    f32x2 q = t * 0.5307027145f + (-0.7265760135f); q = q * t + 0.7107068705f; q = q * t + (-0.142248368f); q = q * t + 0.127414796f; q = q * t;
    const f32x2 s = (v * v) * (-0.72134752044f);
    f32x2 e; e.x = __builtin_amdgcn_exp2f(s.x); e.y = __builtin_amdgcn_exp2f(s.y);
    const f32x2 m = v * (q * e), r = v - m;
    f32x2 o; o.x = v.x < 0.f ? m.x : r.x; o.y = v.y < 0.f ? m.y : r.y; return o;
}

template <int ACT  > struct EpiBf16 {
    static constexpr bool PERM = true, AFTER_DRAIN = false; static_assert(ACT == 0 || ACT == 1, "EpiBf16: ACT is 0 (none) or 1 (gelu_pk)");
    bf16_t* O; int ldc; const float* bias; int split_cols; size_t split_stride; float scale0;
    __device__ __forceinline__ void operator()(const f32x4 (&acc)[2][2][4][2], const Unit& u, int wr, int wc, int fr, int fq) const {
        const int row0 = u.pm * BM + wr * 64 + fr; int colt = u.pn * BM; bf16_t* base = O;
        float sc = 1.f; if (split_cols) { const int t = colt / split_cols; base += (size_t)t * split_stride; colt -= t * split_cols; if (t == 0) sc = scale0; }
        const int col0 = colt + wc * 32 + 8 * fq, bcol0 = u.pn * BM + wc * 32 + 8 * fq;
        f32x4 bv[2][2];
#pragma unroll
        for (int bj = 0; bj < 2; ++bj)
#pragma unroll
            for (int n = 0; n < 2; ++n) bv[bj][n] = bias ? *(const f32x4*)(bias + bcol0 + bj * HALF + 4 * n) : (f32x4){0.f, 0.f, 0.f, 0.f};
#pragma unroll
        for (int ai = 0; ai < 2; ++ai)
#pragma unroll
            for (int m = 0; m < 4; ++m) { bf16_t* rowp = base + (size_t)(row0 + ai * HALF + m * 16) * ldc + col0;
#pragma unroll
                for (int bj = 0; bj < 2; ++bj) { f32x4 v0 = acc[ai][bj][m][0] + bv[bj][0], v1 = acc[ai][bj][m][1] + bv[bj][1];
                    if (ACT == 1) { f32x2 a = gelu_pk((f32x2){v0[0], v0[1]}), b = gelu_pk((f32x2){v0[2], v0[3]}), c = gelu_pk((f32x2){v1[0], v1[1]}), d = gelu_pk((f32x2){v1[2], v1[3]});
                        v0 = (f32x4){a.x, a.y, b.x, b.y}; v1 = (f32x4){c.x, c.y, d.x, d.y}; }
                    v0 = v0 * sc; v1 = v1 * sc; u32x4 w; w.x = cvt_pk_bf16(v0[0], v0[1]); w.y = cvt_pk_bf16(v0[2], v0[3]); w.z = cvt_pk_bf16(v1[0], v1[1]); w.w = cvt_pk_bf16(v1[2], v1[3]);
                    *(u32x4*)(rowp + bj * HALF) = w; } }
    }
};
template <class Epi, class Sched, bool ALIGN_EPI = false, bool SP2 = false>
__device__ __forceinline__ void gemm_phase(PG8_LAS unsigned char* lds, const Gemm g, const Sched& S, const Epi& E) {
    int tid_o = threadIdx.x; asm volatile("" : "+v"(tid_o));
    const int tid = tid_o, wid = __builtin_amdgcn_readfirstlane(tid >> 6), lane = tid & 63, wr = wid >> 2, wc = wid & 3, fr = lane & 15, fq = lane >> 4;
    const int K = g.K, nt = K / BK;
    unsigned voffA[2], voffB[2];
#pragma unroll
    for (int i = 0; i < 2; ++i) { int R, C; stage_rc(tid * 16 + i * 8192, R, C); const int Rb = Epi::PERM ? ((R & ~31) + perm32(R & 31)) : R;
        voffA[i] = (unsigned)(R * g.lda + C) * 2u; voffB[i] = (unsigned)(Rb * g.ldb + C) * 2u; }
    const size_t kstep = (size_t)(BK * 2);
    const size_t hstepA = (size_t)HALF * g.lda * 2, hstepB = (size_t)HALF * g.ldb * 2;
    const size_t tstepA = 2 * hstepA, tstepB = 2 * hstepB;
    const unsigned ldsw = (unsigned)wid * 1024u;
    const int aoff = lds_byte(wr * 64 + fr, fq * 8), boff = lds_byte(wc * 32 + fr, fq * 8);
#define PG8_SA(b, h) (((b) * 2 + (h)) * HTB)
#define PG8_SB(b, h) ((4 + (b) * 2 + (h)) * HTB)
#define PG8_STAGE(bufoff, gbase, voff) do { _Pragma("unroll") for (int _i = 0; _i < 2; ++_i) \
        __builtin_amdgcn_global_load_lds((const unsigned*)((const char*)(gbase) + (voff)[_i]), (PG8_LAS unsigned*)(lds + (bufoff) + ldsw + _i * 8192), 16, 0, 0); } while (0)
#define PG8_LDA(dst, b, h) do { _Pragma("unroll") for (int m = 0; m < 4; ++m) _Pragma("unroll") for (int k = 0; k < 2; ++k) dst[m][k] = *(const PG8_LAS bf16x8*)(lds + PG8_SA(b, h) + aoff + m * 2048 + k * 1024); } while (0)
#define PG8_LDB(dst, b, h) do { _Pragma("unroll") for (int n = 0; n < 2; ++n) _Pragma("unroll") for (int k = 0; k < 2; ++k) dst[n][k] = *(const PG8_LAS bf16x8*)(lds + PG8_SB(b, h) + boff + n * 2048 + k * 1024); } while (0)
#define PG8_MMA(ai, bj, At, Bt) do { __builtin_amdgcn_s_setprio(1); _Pragma("unroll") for (int m = 0; m < 4; ++m) _Pragma("unroll") for (int n = 0; n < 2; ++n) _Pragma("unroll") for (int k = 0; k < 2; ++k) \
        acc[ai][bj][m][n] = __builtin_amdgcn_mfma_f32_16x16x32_bf16(Bt[n][k], At[m][k], acc[ai][bj][m][n], 0, 0, 0); __builtin_amdgcn_s_setprio(0); } while (0)
#define PG8_WAIT_V(n) asm volatile("s_waitcnt vmcnt(" #n ")" ::: "memory")
#define PG8_WAIT_L(n) asm volatile("s_waitcnt lgkmcnt(" #n ")" ::: "memory")
#define PG8_BAR __builtin_amdgcn_s_barrier()
#define PG8_SCHED __builtin_amdgcn_sched_barrier(0)
    Unit cur, nxt; int ui = 0;
    if (!S.next(0, cur)) return;
    f32x4 acc[2][2][4][2];
#pragma unroll
    for (int a = 0; a < 2; ++a)
#pragma unroll
        for (int b = 0; b < 2; ++b)
#pragma unroll
            for (int m = 0; m < 4; ++m)
#pragma unroll
                for (int n = 0; n < 2; ++n) acc[a][b][m][n] = (f32x4){0.f, 0.f, 0.f, 0.f};
    bf16x8 At[4][2], B0[2][2], B1[2][2];
    const char* cA = (const char*)g.A + (size_t)cur.pm * tstepA; const char* cB = (const char*)g.Bt + (size_t)cur.pn * tstepB;
    S.a_ready(cur);
    if constexpr (SP2) {
        PG8_STAGE(PG8_SB(0, 0), cB, voffB); PG8_STAGE(PG8_SB(0, 1), cB + hstepB, voffB); PG8_STAGE(PG8_SA(0, 0), cA, voffA); PG8_STAGE(PG8_SA(0, 1), cA + hstepA, voffA);
        if (wr == 1) PG8_BAR;
        PG8_WAIT_V(2); PG8_BAR;
        PG8_STAGE(PG8_SB(1, 0), cB + kstep, voffB); PG8_STAGE(PG8_SA(1, 0), cA + kstep, voffA); PG8_STAGE(PG8_SB(1, 1), cB + hstepB + kstep, voffB);
        PG8_WAIT_V(6); PG8_BAR;
    } else {
        PG8_STAGE(PG8_SB(0, 0), cB, voffB); PG8_STAGE(PG8_SA(0, 0), cA, voffA); PG8_STAGE(PG8_SB(0, 1), cB + hstepB, voffB); PG8_STAGE(PG8_SA(0, 1), cA + hstepA, voffA);
        if (wr == 1) PG8_BAR;
        PG8_WAIT_V(4); PG8_BAR;
        PG8_STAGE(PG8_SB(1, 0), cB + kstep, voffB); PG8_STAGE(PG8_SA(1, 0), cA + kstep, voffA); PG8_STAGE(PG8_SB(1, 1), cB + hstepB + kstep, voffB);
        PG8_WAIT_V(6); PG8_BAR;
    }
    for (;;) {
        const bool has_next = S.next(ui + 1, nxt);
        const char* nA = has_next ? (const char*)g.A + (size_t)nxt.pm * tstepA : cA; const char* nB = has_next ? (const char*)g.Bt + (size_t)nxt.pn * tstepB : cB;
        for (int t = 0; t < nt; t += 2) {
            const bool last = (t == nt - 2);
            const char* a1 = cA + (size_t)(t + 1) * kstep;
            const char* a2 = last ? nA : cA + (size_t)(t + 2) * kstep; const char* b2 = last ? nB : cB + (size_t)(t + 2) * kstep;
            const char* a3 = a2 + kstep; const char* b3 = b2 + kstep;
            if (last && has_next) S.a_ready(nxt);
            if constexpr (SP2) {
            PG8_LDB(B0, 0, 0); PG8_LDB(B1, 0, 1); PG8_SCHED; PG8_LDA(At, 0, 0); PG8_STAGE(PG8_SA(1, 1), a1 + hstepA, voffA);
            PG8_WAIT_V(8); PG8_WAIT_L(0); PG8_BAR; PG8_MMA(0, 0, At, B0); PG8_MMA(0, 1, At, B1); PG8_BAR; PG8_SCHED;
            PG8_LDA(At, 0, 1); PG8_STAGE(PG8_SB(0, 0), b2, voffB); PG8_STAGE(PG8_SB(0, 1), b2 + hstepB, voffB); PG8_STAGE(PG8_SA(0, 0), a2, voffA);
            PG8_WAIT_V(8); PG8_WAIT_L(0); PG8_BAR; PG8_MMA(1, 0, At, B0); PG8_MMA(1, 1, At, B1); PG8_BAR; PG8_SCHED;
            PG8_LDB(B0, 1, 0); PG8_LDB(B1, 1, 1); PG8_SCHED; PG8_LDA(At, 1, 0); PG8_STAGE(PG8_SA(0, 1), a2 + hstepA, voffA);
            PG8_WAIT_V(8); PG8_WAIT_L(0); PG8_BAR; PG8_MMA(0, 0, At, B0); PG8_MMA(0, 1, At, B1); PG8_BAR; PG8_SCHED;
            PG8_LDA(At, 1, 1); PG8_STAGE(PG8_SB(1, 0), b3, voffB); PG8_STAGE(PG8_SB(1, 1), b3 + hstepB, voffB); PG8_STAGE(PG8_SA(1, 0), a3, voffA);
            PG8_WAIT_V(8); PG8_WAIT_L(0); PG8_BAR; PG8_MMA(1, 0, At, B0); PG8_MMA(1, 1, At, B1); PG8_BAR; PG8_SCHED;
            } else {
            PG8_LDB(B0, 0, 0); PG8_SCHED; PG8_LDA(At, 0, 0); PG8_STAGE(PG8_SA(1, 1), a1 + hstepA, voffA);
            PG8_WAIT_L(8); PG8_BAR; PG8_WAIT_L(0); PG8_MMA(0, 0, At, B0); PG8_BAR; PG8_SCHED;
            PG8_LDB(B1, 0, 1); PG8_STAGE(PG8_SB(0, 0), b2, voffB);
            PG8_BAR; PG8_WAIT_L(0); PG8_MMA(0, 1, At, B1); PG8_BAR;
            PG8_LDA(At, 0, 1); PG8_STAGE(PG8_SA(0, 0), a2, voffA);
            PG8_BAR; PG8_WAIT_L(0); PG8_MMA(1, 0, At, B0); PG8_BAR; PG8_SCHED;
            PG8_STAGE(PG8_SB(0, 1), b2 + hstepB, voffB);
            PG8_WAIT_V(6); PG8_BAR; PG8_MMA(1, 1, At, B1); PG8_BAR;
            PG8_LDB(B0, 1, 0); PG8_SCHED; PG8_LDA(At, 1, 0); PG8_STAGE(PG8_SA(0, 1), a2 + hstepA, voffA);
            PG8_WAIT_L(8); PG8_BAR; PG8_WAIT_L(0); PG8_MMA(0, 0, At, B0); PG8_BAR; PG8_SCHED;
            PG8_LDB(B1, 1, 1); PG8_STAGE(PG8_SB(1, 0), b3, voffB);
            PG8_BAR; PG8_WAIT_L(0); PG8_MMA(0, 1, At, B1); PG8_BAR;
            PG8_LDA(At, 1, 1); PG8_STAGE(PG8_SA(1, 0), a3, voffA);
            PG8_BAR; PG8_WAIT_L(0); PG8_MMA(1, 0, At, B0); PG8_BAR; PG8_SCHED;
            PG8_STAGE(PG8_SB(1, 1), b3 + hstepB, voffB);
            PG8_WAIT_V(6); PG8_BAR; PG8_MMA(1, 1, At, B1); PG8_BAR;
            }
        }
        if constexpr (ALIGN_EPI) { if (wr == 0) PG8_BAR; }
        if constexpr (!Epi::AFTER_DRAIN) { E(acc, cur, wr, wc, fr, fq); S.done(cur); }
        if (!has_next) break;
#pragma unroll
        for (int a = 0; a < 2; ++a)
#pragma unroll
            for (int b = 0; b < 2; ++b)
#pragma unroll
                for (int m = 0; m < 4; ++m)
#pragma unroll
                    for (int n = 0; n < 2; ++n) acc[a][b][m][n] = (f32x4){0.f, 0.f, 0.f, 0.f};
        cur = nxt; cA = nA; cB = nB; ++ui;
        if constexpr (ALIGN_EPI) { if (wr == 1) PG8_BAR; }
    }
    PG8_WAIT_V(0);
    if constexpr (!ALIGN_EPI) { if (wr == 0) PG8_BAR; }
    PG8_BAR;
    if constexpr (Epi::AFTER_DRAIN) { E.fused(acc, cur, wr, wc, fr, fq, lds, wid, lane); S.done(cur); }
#undef PG8_SA
#undef PG8_SB
#undef PG8_STAGE
#undef PG8_LDA
#undef PG8_LDB
#undef PG8_MMA
#undef PG8_WAIT_V
#undef PG8_WAIT_L
#undef PG8_BAR
#undef PG8_SCHED
}
}

namespace pg8 {
struct EpiF32 {
    static constexpr bool PERM = true, AFTER_DRAIN = false;
    float* O; int ldc;
    __device__ __forceinline__ void operator()(const f32x4 (&acc)[2][2][4][2], const Unit& u, int wr, int wc, int fr, int fq) const {
        const int row0 = u.pm * BM + wr * 64 + fr, col0 = u.pn * BM + wc * 32 + 8 * fq;
#pragma unroll
        for (int ai = 0; ai < 2; ++ai)
#pragma unroll
            for (int m = 0; m < 4; ++m) { float* rowp = O + (size_t)(row0 + ai * HALF + m * 16) * ldc + col0;
#pragma unroll
                for (int bj = 0; bj < 2; ++bj) { *(f32x4*)(rowp + bj * HALF) = acc[ai][bj][m][0]; *(f32x4*)(rowp + bj * HALF + 4) = acc[ai][bj][m][1]; } }
    }
};

struct XcdOrder {
    int ppx, ntile, rank, nb, pm0;
    __device__ void init(int M, int N, int vx, int rank_, int nb_) { ppx = (M / BM) / NXCD; ntile = ppx * (N / BM); rank = rank_; nb = nb_; pm0 = vx * ppx; }
    __device__ bool next(int i, Unit& u) const { const int t = rank + i * nb; if (t >= ntile) return false; u.pm = pm0 + t % ppx; u.pn = t / ppx; return true; }
    __device__ __forceinline__ void a_ready(const Unit&) const {}
    __device__ __forceinline__ void done(const Unit&) const {}
};
struct VtOrder {
    int vx, r2, nb2;
    __device__ void init(int vx_, int rank, int nb) { vx = vx_; r2 = rank - nb / 2; nb2 = nb - nb / 2; }
    __device__ bool next(int i, Unit& u) const { if (r2 < 0) return false; const int t = r2 + i * nb2; if (t >= 16) return false; u.pm = t & 3; u.pn = vx * 4 + (t >> 2); return true; }
    __device__ __forceinline__ void a_ready(const Unit&) const {}
    __device__ __forceinline__ void done(const Unit&) const {}
};
struct EpiUp {
    static constexpr bool PERM = true, AFTER_DRAIN = false;
    bf16_t* O; int ldc; bf16_t* side; int acols;
    __device__ __forceinline__ void operator()(const f32x4 (&acc)[2][2][4][2], const Unit& u, int wr, int wc, int fr, int fq) const {
        const int row0 = u.pm * BM + wr * 64 + fr, col0 = u.pn * BM + wc * 32 + 8 * fq;
#pragma unroll
        for (int ai = 0; ai < 2; ++ai)
#pragma unroll
            for (int m = 0; m < 4; ++m) { const int row = row0 + ai * HALF + m * 16; bf16_t* rowp = O + (size_t)row * ldc + col0;
#pragma unroll
                for (int bj = 0; bj < 2; ++bj) { const f32x4 v0 = acc[ai][bj][m][0], v1 = acc[ai][bj][m][1];
                    u32x4 w; w.x = cvt_pk_bf16(v0[0], v0[1]); w.y = cvt_pk_bf16(v0[2], v0[3]); w.z = cvt_pk_bf16(v1[0], v1[1]); w.w = cvt_pk_bf16(v1[2], v1[3]);
                    *(u32x4*)(rowp + bj * HALF) = w;
                    if ((row & 1023) >= 1022 && col0 + bj * HALF < acols) *(u32x4*)(side + ((size_t)(row >> 10) * 2 + (row & 1)) * acols + col0 + bj * HALF) = w; } }
    }
};

struct DiagOrder {
    int vb, nvb;
    __device__ bool next(int i, Unit& u) const { const int t = vb + i * nvb; if (t >= 128) return false; u.pm = t; u.pn = t >> 1; return true; }
    __device__ __forceinline__ void a_ready(const Unit&) const {}
    __device__ __forceinline__ void done(const Unit&) const {}
};
struct EpiS {
    static constexpr bool PERM = true, AFTER_DRAIN = false;
    float* S;
    __device__ __forceinline__ void operator()(const f32x4 (&acc)[2][2][4][2], const Unit& u, int wr, int wc, int fr, int fq) const {
        const int row0 = u.pm * BM + wr * 64 + fr, col0 = wc * 32 + 8 * fq;
#pragma unroll
        for (int ai = 0; ai < 2; ++ai)
#pragma unroll
            for (int m = 0; m < 4; ++m) { float* rowp = S + (size_t)(row0 + ai * HALF + m * 16) * 128 + col0; *(f32x4*)rowp = acc[ai][0][m][0]; *(f32x4*)(rowp + 4) = acc[ai][0][m][1]; }
    }
};
struct EpiY {
    static constexpr bool PERM = true, AFTER_DRAIN = false;
    const bf16_t* UX; const float* dsk; bf16_t* YG;
    __device__ __forceinline__ void operator()(const f32x4 (&acc)[2][2][4][2], const Unit& u, int wr, int wc, int fr, int fq) const {
        const int g = u.pn, row0 = u.pm * BM + wr * 64 + fr;
#pragma unroll
        for (int bj = 0; bj < 2; ++bj) {
            const int col = bj * HALF + wc * 32 + 8 * fq, t = col >> 4, c0 = col & 15;
            const f32x4 d0 = *(const f32x4*)(dsk + g * 16 + c0), d1 = *(const f32x4*)(dsk + g * 16 + c0 + 4);
            u32x4 uwv[2][4];
#pragma unroll
            for (int ai = 0; ai < 2; ++ai)
#pragma unroll
                for (int m = 0; m < 4; ++m) uwv[ai][m] = *(const u32x4*)(UX + (size_t)(row0 + ai * HALF + m * 16) * 384 + col);
#pragma unroll
            for (int ai = 0; ai < 2; ++ai)
#pragma unroll
                for (int m = 0; m < 4; ++m) {
                    const int row = row0 + ai * HALF + m * 16, seq = row - g * 512;
                    const u32x4 uw = uwv[ai][m];
                    const f32x4 a0 = acc[ai][bj][m][0], a1 = acc[ai][bj][m][1];
                    float y[8];
                    y[0] = a0[0] + d0[0] * __builtin_bit_cast(float, uw.x << 16); y[1] = a0[1] + d0[1] * __builtin_bit_cast(float, uw.x & 0xffff0000u);
                    y[2] = a0[2] + d0[2] * __builtin_bit_cast(float, uw.y << 16); y[3] = a0[3] + d0[3] * __builtin_bit_cast(float, uw.y & 0xffff0000u);
                    y[4] = a1[0] + d1[0] * __builtin_bit_cast(float, uw.z << 16); y[5] = a1[1] + d1[1] * __builtin_bit_cast(float, uw.z & 0xffff0000u);
                    y[6] = a1[2] + d1[2] * __builtin_bit_cast(float, uw.w << 16); y[7] = a1[3] + d1[3] * __builtin_bit_cast(float, uw.w & 0xffff0000u);
#pragma unroll
                    for (int e = 0; e < 8; ++e) { const float x = y[e], q = 0.7978845608028654f * (x + 0.044715f * x * x * x); y[e] = x * __builtin_amdgcn_rcpf(1.0f + __builtin_amdgcn_exp2f(-2.885390081777927f * q)); }
                    u32x4 w; w.x = cvt_pk_bf16(y[0], y[1]); w.y = cvt_pk_bf16(y[2], y[3]); w.z = cvt_pk_bf16(y[4], y[5]); w.w = cvt_pk_bf16(y[6], y[7]);
                    { bf16_t* yp = YG + ((size_t)seq * 16 + t) * 1024 + g * 16 + c0; asm volatile("global_store_dwordx4 %0, %1, off sc1\n\ts_nop 1" :: "v"(yp), "v"(w) : "memory"); }
                }
            asm volatile("" ::: "memory");
        }
    }
};

struct EpiRes {
    static constexpr bool PERM = true, AFTER_DRAIN = false;
    const float* base; const float* gate; float* O; int ldc;
    __device__ __forceinline__ void operator()(const f32x4 (&acc)[2][2][4][2], const Unit& u, int wr, int wc, int fr, int fq) const {
        const int row0 = u.pm * BM + wr * 64 + fr, col0 = u.pn * BM + wc * 32 + 8 * fq; const float* gp = gate + ((u.pm * BM) >> 12) * 12288 + col0;
        f32x4 gv[2][2];
#pragma unroll
        for (int bj = 0; bj < 2; ++bj) { gv[bj][0] = *(const f32x4*)(gp + bj * HALF); gv[bj][1] = *(const f32x4*)(gp + bj * HALF + 4); }
#pragma unroll
        for (int ai = 0; ai < 2; ++ai) {
            f32x4 xv[4][2][2];
#pragma unroll
            for (int m = 0; m < 4; ++m) { const size_t off = (size_t)(row0 + ai * HALF + m * 16) * ldc + col0;
#pragma unroll
                for (int bj = 0; bj < 2; ++bj) { xv[m][bj][0] = *(const f32x4*)(base + off + bj * HALF); xv[m][bj][1] = *(const f32x4*)(base + off + bj * HALF + 4); } }
#pragma unroll
            for (int m = 0; m < 4; ++m) { const size_t off = (size_t)(row0 + ai * HALF + m * 16) * ldc + col0;
#pragma unroll
                for (int bj = 0; bj < 2; ++bj) { *(f32x4*)(O + off + bj * HALF) = xv[m][bj][0] + gv[bj][0] * acc[ai][bj][m][0]; *(f32x4*)(O + off + bj * HALF + 4) = xv[m][bj][1] + gv[bj][1] * acc[ai][bj][m][1]; } }
            asm volatile("" ::: "memory");
        }
    }
};
struct EpiGlu {
    static constexpr bool PERM = true, AFTER_DRAIN = false;
    const bf16_t* Y; int ldy; const float* bias; bf16_t* O; int ldo;
    __device__ __forceinline__ void operator()(const f32x4 (&acc)[2][2][4][2], const Unit& u, int wr, int wc, int fr, int fq) const {
        const int row0 = u.pm * BM + wr * 64 + fr, col0 = u.pn * BM + wc * 32 + 8 * fq;
        f32x4 bv[2][2];
#pragma unroll
        for (int bj = 0; bj < 2; ++bj) { bv[bj][0] = *(const f32x4*)(bias + col0 + bj * HALF); bv[bj][1] = *(const f32x4*)(bias + col0 + bj * HALF + 4); }
#pragma unroll
        for (int ai = 0; ai < 2; ++ai) {
            u32x4 ywv[4][2];
#pragma unroll
            for (int m = 0; m < 4; ++m)
#pragma unroll
                for (int bj = 0; bj < 2; ++bj) ywv[m][bj] = *(const u32x4*)(Y + (size_t)(row0 + ai * HALF + m * 16) * ldy + col0 + bj * HALF);
#pragma unroll
            for (int m = 0; m < 4; ++m) { const int row = row0 + ai * HALF + m * 16;
#pragma unroll
                for (int bj = 0; bj < 2; ++bj) { const int col = col0 + bj * HALF; const u32x4 yw = ywv[m][bj];
                    const f32x4 z0 = acc[ai][bj][m][0] + bv[bj][0], z1 = acc[ai][bj][m][1] + bv[bj][1]; float o[8];
                    o[0] = __builtin_bit_cast(float, yw.x << 16) * __builtin_amdgcn_rcpf(1.f + __builtin_amdgcn_exp2f(-1.4426950408889634f * z0[0])); o[1] = __builtin_bit_cast(float, yw.x & 0xffff0000u) * __builtin_amdgcn_rcpf(1.f + __builtin_amdgcn_exp2f(-1.4426950408889634f * z0[1]));
                    o[2] = __builtin_bit_cast(float, yw.y << 16) * __builtin_amdgcn_rcpf(1.f + __builtin_amdgcn_exp2f(-1.4426950408889634f * z0[2])); o[3] = __builtin_bit_cast(float, yw.y & 0xffff0000u) * __builtin_amdgcn_rcpf(1.f + __builtin_amdgcn_exp2f(-1.4426950408889634f * z0[3]));
                    o[4] = __builtin_bit_cast(float, yw.z << 16) * __builtin_amdgcn_rcpf(1.f + __builtin_amdgcn_exp2f(-1.4426950408889634f * z1[0])); o[5] = __builtin_bit_cast(float, yw.z & 0xffff0000u) * __builtin_amdgcn_rcpf(1.f + __builtin_amdgcn_exp2f(-1.4426950408889634f * z1[1]));
                    o[6] = __builtin_bit_cast(float, yw.w << 16) * __builtin_amdgcn_rcpf(1.f + __builtin_amdgcn_exp2f(-1.4426950408889634f * z1[2])); o[7] = __builtin_bit_cast(float, yw.w & 0xffff0000u) * __builtin_amdgcn_rcpf(1.f + __builtin_amdgcn_exp2f(-1.4426950408889634f * z1[3]));
                    u32x4 w; w.x = cvt_pk_bf16(o[0], o[1]); w.y = cvt_pk_bf16(o[2], o[3]); w.z = cvt_pk_bf16(o[4], o[5]); w.w = cvt_pk_bf16(o[6], o[7]);
                    *(u32x4*)(O + (size_t)row * ldo + col) = w; } }
            asm volatile("" ::: "memory"); }
    }
};

struct EpiQKU {
    static constexpr bool PERM = true, AFTER_DRAIN = false;
    bf16_t* QB; bf16_t* KB; bf16_t* UX; const float* qg; const float* kg; float qscale, eps;
    __device__ __forceinline__ void operator()(const f32x4 (&acc)[2][2][4][2], const Unit& u, int wr, int wc, int fr, int fq) const {
        const int row0 = u.pm * BM + wr * 64 + fr, kind = u.pn >> 2, lc0 = (u.pn & 3) * BM + 64 * wc + 8 * fq;
        if (kind < 2) {
            const float* gp = kind == 0 ? qg : kg; const float gs = kind == 0 ? qscale : 1.0f; bf16_t* O = kind == 0 ? QB : KB;
            f32x4 gv[2][2];
#pragma unroll
            for (int bj = 0; bj < 2; ++bj) { gv[bj][0] = *(const f32x4*)(gp + 32 * bj + 8 * fq) * gs; gv[bj][1] = *(const f32x4*)(gp + 32 * bj + 8 * fq + 4) * gs; }
#pragma unroll
            for (int ai = 0; ai < 2; ++ai)
#pragma unroll
                for (int m = 0; m < 4; ++m) {
                    float ss = 0.f;
#pragma unroll
                    for (int bj = 0; bj < 2; ++bj)
#pragma unroll
                        for (int n = 0; n < 2; ++n) { const f32x4 x = acc[ai][bj][m][n]; ss += (x[0] * x[0] + x[1] * x[1]) + (x[2] * x[2] + x[3] * x[3]); }
                    ss += __shfl_xor(ss, 16); ss += __shfl_xor(ss, 32);
                    const float rs = rsqrtf(ss * (1.0f / 64.0f) + eps);
                    bf16_t* rowp = O + (size_t)(row0 + ai * HALF + m * 16) * 1024 + lc0;
#pragma unroll
                    for (int bj = 0; bj < 2; ++bj) { const f32x4 v0 = acc[ai][bj][m][0] * rs * gv[bj][0], v1 = acc[ai][bj][m][1] * rs * gv[bj][1];
                        u32x4 w; w.x = cvt_pk_bf16(v0[0], v0[1]); w.y = cvt_pk_bf16(v0[2], v0[3]); w.z = cvt_pk_bf16(v1[0], v1[1]); w.w = cvt_pk_bf16(v1[2], v1[3]);
                        *(u32x4*)(rowp + 32 * bj) = w; }
                }
        } else {
#pragma unroll
            for (int ai = 0; ai < 2; ++ai)
#pragma unroll
                for (int m = 0; m < 4; ++m) { const int row = row0 + ai * HALF + m * 16;
#pragma unroll
                    for (int bj = 0; bj < 2; ++bj) { const int lu = lc0 + 32 * bj, g = lu >> 4, c0 = lu & 15; const f32x4 v0 = acc[ai][bj][m][0], v1 = acc[ai][bj][m][1];
                        u32x4 w; w.x = cvt_pk_bf16(v0[0], v0[1]); w.y = cvt_pk_bf16(v0[2], v0[3]); w.z = cvt_pk_bf16(v1[0], v1[1]); w.w = cvt_pk_bf16(v1[2], v1[3]);
                        *(u32x4*)(UX + ((size_t)g * 512 + (row >> 4)) * 384 + (row & 15) * 16 + c0) = w; } }
        }
    }
};

__device__ __forceinline__ float dpp_ror1(float v) { return __builtin_bit_cast(float, __builtin_amdgcn_update_dpp(0, __builtin_bit_cast(int, v), 0x121, 0xf, 0xf, false)); }
__device__ __forceinline__ float dpp_ror2(float v) { return __builtin_bit_cast(float, __builtin_amdgcn_update_dpp(0, __builtin_bit_cast(int, v), 0x122, 0xf, 0xf, false)); }
struct EpiUpAct {
    static constexpr bool PERM = true, AFTER_DRAIN = false;
    bf16_t* ACT; bf16_t* sideA; bf16_t* sideB; const float* cw; const float* cbias; int nf;
    __device__ __forceinline__ void operator()(const f32x4 (&acc)[2][2][4][2], const Unit& u, int wr, int wc, int fr, int fq) const {
        const int f0 = u.pn * HALF + wc * 32 + 8 * fq;
        float w0[8], w1[8], w2[8], cb[8];
#pragma unroll
        for (int h = 0; h < 2; ++h) { const f32x4 a = *(const f32x4*)(cw + f0 + 4 * h), b = *(const f32x4*)(cw + nf + f0 + 4 * h), c = *(const f32x4*)(cw + 2 * nf + f0 + 4 * h), d = *(const f32x4*)(cbias + f0 + 4 * h);
#pragma unroll
            for (int e = 0; e < 4; ++e) { w0[4 * h + e] = a[e]; w1[4 * h + e] = b[e]; w2[4 * h + e] = c[e]; cb[4 * h + e] = d[e]; } }
#pragma unroll
        for (int ai = 0; ai < 2; ++ai) {
            const int rowb = u.pm * BM + ai * HALF + wr * 64, blk = rowb >> 6;
#pragma unroll
            for (int m = 0; m < 4; ++m) {
                const int row = rowb + m * 16 + fr;
                float o[8];
#pragma unroll
                for (int e = 0; e < 8; ++e) {
                    const float cur = acc[ai][0][m][e >> 2][e & 3], prv = (m > 0) ? acc[ai][0][m > 0 ? m - 1 : 0][e >> 2][e & 3] : 0.f, gg = acc[ai][1][m][e >> 2][e & 3];
                    const float p1 = dpp_ror1(fr == 15 ? prv : cur), p2 = dpp_ror2(fr >= 14 ? prv : cur);
                    const float x = w0[e] * p2 + w1[e] * p1 + w2[e] * cur + cb[e];
                    const float q = 0.7978845608028654f * (x + 0.044715f * x * x * x);
                    o[e] = x * __builtin_amdgcn_rcpf(1.0f + __builtin_amdgcn_exp2f(-2.885390081777927f * q)) * gg;
                }
                if (m > 0 || fr >= 2) { u32x4 w; w.x = cvt_pk_bf16(o[0], o[1]); w.y = cvt_pk_bf16(o[2], o[3]); w.z = cvt_pk_bf16(o[4], o[5]); w.w = cvt_pk_bf16(o[6], o[7]);
                    { bf16_t* ap = ACT + (size_t)row * nf + f0; asm volatile("global_store_dwordx4 %0, %1, off sc1\n\ts_nop 1" :: "v"(ap), "v"(w) : "memory"); } }
                else { const f32x4 a0 = acc[ai][0][0][0], a1 = acc[ai][0][0][1], g0 = acc[ai][1][0][0], g1 = acc[ai][1][0][1];
                    u32x4 wa, wg; wa.x = cvt_pk_bf16(a0[0], a0[1]); wa.y = cvt_pk_bf16(a0[2], a0[3]); wa.z = cvt_pk_bf16(a1[0], a1[1]); wa.w = cvt_pk_bf16(a1[2], a1[3]);
                    wg.x = cvt_pk_bf16(g0[0], g0[1]); wg.y = cvt_pk_bf16(g0[2], g0[3]); wg.z = cvt_pk_bf16(g1[0], g1[1]); wg.w = cvt_pk_bf16(g1[2], g1[3]);
                    bf16_t* sb = sideB + ((size_t)(blk * 2 + fr) * 2) * nf + f0; *(u32x4*)sb = wa; *(u32x4*)(sb + nf) = wg; }
                if (m == 3 && fr >= 14) { const f32x4 a0 = acc[ai][0][3][0], a1 = acc[ai][0][3][1];
                    u32x4 wa; wa.x = cvt_pk_bf16(a0[0], a0[1]); wa.y = cvt_pk_bf16(a0[2], a0[3]); wa.z = cvt_pk_bf16(a1[0], a1[1]); wa.w = cvt_pk_bf16(a1[2], a1[3]);
                    *(u32x4*)(sideA + (size_t)(blk * 2 + (fr - 14)) * nf + f0) = wa; }
            }
        }
    }
};

struct OneUnit {
    int pm, pn;
    __device__ bool next(int i, Unit& u) const { if (i) return false; u.pm = pm; u.pn = pn; return true; }
    __device__ __forceinline__ void a_ready(const Unit&) const {}
    __device__ __forceinline__ void done(const Unit&) const {}
};

struct EpiResOutB {
    static constexpr bool PERM = true, AFTER_DRAIN = false;
    const float* base; const float* gate; bf16_t* O; int ldc;
    __device__ __forceinline__ void operator()(const f32x4 (&acc)[2][2][4][2], const Unit& u, int wr, int wc, int fr, int fq) const {
        const int row0 = u.pm * BM + wr * 64 + fr, col0 = u.pn * BM + wc * 32 + 8 * fq; const float* gp = gate + ((u.pm * BM) >> 12) * 12288 + col0;
        f32x4 gv[2][2];
#pragma unroll
        for (int bj = 0; bj < 2; ++bj) { gv[bj][0] = *(const f32x4*)(gp + bj * HALF); gv[bj][1] = *(const f32x4*)(gp + bj * HALF + 4); }
#pragma unroll
        for (int ai = 0; ai < 2; ++ai) {
            f32x4 xv[4][2][2];
#pragma unroll
            for (int m = 0; m < 4; ++m) { const size_t off = (size_t)(row0 + ai * HALF + m * 16) * ldc + col0;
#pragma unroll
                for (int bj = 0; bj < 2; ++bj) { xv[m][bj][0] = __builtin_nontemporal_load((const f32x4*)(base + off + bj * HALF)); xv[m][bj][1] = __builtin_nontemporal_load((const f32x4*)(base + off + bj * HALF + 4)); } }
#pragma unroll
            for (int m = 0; m < 4; ++m) { const size_t off = (size_t)(row0 + ai * HALF + m * 16) * ldc + col0;
#pragma unroll
                for (int bj = 0; bj < 2; ++bj) { const f32x4 v0 = xv[m][bj][0] + gv[bj][0] * acc[ai][bj][m][0], v1 = xv[m][bj][1] + gv[bj][1] * acc[ai][bj][m][1];
                    u32x4 w; w.x = cvt_pk_bf16(v0[0], v0[1]); w.y = cvt_pk_bf16(v0[2], v0[3]); w.z = cvt_pk_bf16(v1[0], v1[1]); w.w = cvt_pk_bf16(v1[2], v1[3]);
                    *(u32x4*)(O + off + bj * HALF) = w; } }
            asm volatile("" ::: "memory");
        }
    }
};
struct EpiResInB {
    static constexpr bool PERM = true, AFTER_DRAIN = false;
    const bf16_t* base; const float* gate; float* O; int ldc;
    __device__ __forceinline__ void operator()(const f32x4 (&acc)[2][2][4][2], const Unit& u, int wr, int wc, int fr, int fq) const {
        const int row0 = u.pm * BM + wr * 64 + fr, col0 = u.pn * BM + wc * 32 + 8 * fq; const float* gp = gate + ((u.pm * BM) >> 12) * 12288 + col0;
        f32x4 gv[2][2];
#pragma unroll
        for (int bj = 0; bj < 2; ++bj) { gv[bj][0] = *(const f32x4*)(gp + bj * HALF); gv[bj][1] = *(const f32x4*)(gp + bj * HALF + 4); }
#pragma unroll
        for (int ai = 0; ai < 2; ++ai) {
            u32x4 xw[4][2];
#pragma unroll
            for (int m = 0; m < 4; ++m)
#pragma unroll
                for (int bj = 0; bj < 2; ++bj) xw[m][bj] = *(const u32x4*)(base + (size_t)(row0 + ai * HALF + m * 16) * ldc + col0 + bj * HALF);
#pragma unroll
            for (int m = 0; m < 4; ++m) { const size_t off = (size_t)(row0 + ai * HALF + m * 16) * ldc + col0;
#pragma unroll
                for (int bj = 0; bj < 2; ++bj) { const u32x4 q = xw[m][bj];
                    const f32x4 x0 = {__builtin_bit_cast(float, q.x << 16), __builtin_bit_cast(float, q.x & 0xffff0000u), __builtin_bit_cast(float, q.y << 16), __builtin_bit_cast(float, q.y & 0xffff0000u)};
                    const f32x4 x1 = {__builtin_bit_cast(float, q.z << 16), __builtin_bit_cast(float, q.z & 0xffff0000u), __builtin_bit_cast(float, q.w << 16), __builtin_bit_cast(float, q.w & 0xffff0000u)};
                    __builtin_nontemporal_store(x0 + gv[bj][0] * acc[ai][bj][m][0], (f32x4*)(O + off + bj * HALF)); __builtin_nontemporal_store(x1 + gv[bj][1] * acc[ai][bj][m][1], (f32x4*)(O + off + bj * HALF + 4)); } }
            asm volatile("" ::: "memory");
        }
    }
};
}

#define LAS __attribute__((address_space(3)))
typedef unsigned short bf16_t;
typedef float f32x4 __attribute__((ext_vector_type(4)));
typedef unsigned u32x4 __attribute__((ext_vector_type(4)));
typedef unsigned u32x2 __attribute__((ext_vector_type(2)));

constexpr int BATCH = 2, SEQ = 4096, DM = 2048, NTOK = BATCH * SEQ;
constexpr int NH = 8, HD = 64, VD = 128, NG = 64, DFF = 5632, NQKU = 3072;
constexpr float EPS = 1e-6f, LOG2E = 1.4426950408889634f, C2 = 0.125f * LOG2E;
constexpr int LDS_BYTES = 147456;
constexpr int NTHREADS = 512, NWAVES = 8;

constexpr size_t MiB = (size_t)1 << 20;
constexpr size_t WS_CTL = 0, WS_MOD = 1 * MiB, WS_ZERO_BYTES = 2 * MiB;
constexpr size_t WS_WUP = 2 * MiB, WS_WDN = 46 * MiB, WS_X1 = 68 * MiB, WS_HB = 132 * MiB, WS_APRE = 164 * MiB;
constexpr size_t WS_WIN = 164 * MiB, WS_WGLU = 180 * MiB, WS_WOUT = 358 * MiB  , WS_QB = 190 * MiB, WS_KB = 206 * MiB, WS_VT = 222 * MiB;
constexpr size_t WS_UX = 238 * MiB, WS_MIX = 262 * MiB, WS_YG = 294 * MiB, WS_SBUF = 310 * MiB, WS_AMAT = 326 * MiB, WS_WMAT = 340 * MiB, WS_SIDEA = 348 * MiB, WS_SIDEB = 352 * MiB, WS_END = 366 * MiB;
constexpr size_t WS_SIDE = 64 * 1024;

#define GRID_SYNC_CG() do { asm volatile("s_waitcnt vmcnt(0) lgkmcnt(0)" ::: "memory"); grid.sync(); \
    if (__builtin_amdgcn_readfirstlane((int)(threadIdx.x >> 6)) == 0) { __builtin_amdgcn_fence(__ATOMIC_ACQUIRE, "agent"); asm volatile("s_waitcnt vmcnt(0)" ::: "memory"); } __syncthreads(); } while (0)
#define GRID_SYNC() do { xcd_barrier(xbar); } while (0)
#define XCD_SYNC() do { asm volatile("s_waitcnt vmcnt(0) lgkmcnt(0)" ::: "memory"); __syncthreads(); \
    if (threadIdx.x == 0) { const unsigned old_ = __hip_atomic_fetch_add(ctl + 64 * (20 + vx), 1u, __ATOMIC_RELAXED, __HIP_MEMORY_SCOPE_AGENT), gen_ = old_ / (unsigned)nb; \
        if (old_ + 1u == (gen_ + 1u) * (unsigned)nb) __hip_atomic_fetch_add(ctl + 64 * (28 + vx), 1u, __ATOMIC_RELAXED, __HIP_MEMORY_SCOPE_AGENT); \
        else while (__hip_atomic_load(ctl + 64 * (28 + vx), __ATOMIC_RELAXED, __HIP_MEMORY_SCOPE_AGENT) == gen_) __builtin_amdgcn_s_sleep(1); \
        __builtin_amdgcn_fence(__ATOMIC_ACQUIRE, "agent"); asm volatile("s_waitcnt vmcnt(0)" ::: "memory"); } \
    __syncthreads(); } while (0)

#define XB_TMO      128
#define XB_XCNT(j)  (256  + 64 * (j))
#define XB_XSUB(j)  (1280 + 64 * (j))
#define XB_XGEN(j)  (2304 + 64 * (j))
#define XB_TOP      3328
#define XB_TOPGEN   3392
#define XCD_BAR_WORDS 3456
#define XB_SPIN_CAP (1u << 18)

__device__ __forceinline__ unsigned xb_ld(unsigned* p)              { return __hip_atomic_load(p, __ATOMIC_RELAXED, __HIP_MEMORY_SCOPE_AGENT); }
__device__ __forceinline__ unsigned xb_add(unsigned* p, unsigned v) { return __hip_atomic_fetch_add(p, v, __ATOMIC_RELAXED, __HIP_MEMORY_SCOPE_AGENT); }
__device__ __forceinline__ unsigned xb_xcc_id() { return (unsigned)__builtin_amdgcn_s_getreg((3 << 11) | 20) & 0xFu; }
#define XB_SPIN(cond, bar) do { unsigned _sp = 0; while (cond) { __builtin_amdgcn_s_sleep(1); \
    if ((++_sp & 255u) == 0u) { if (xb_ld(&(bar)[XB_TMO])) break; if (_sp > XB_SPIN_CAP) { atomicAdd(&(bar)[XB_TMO], 1u); break; } } } } while (0)

struct XcdBarrier {
    unsigned* bar; unsigned x;
    volatile LAS unsigned* st;
};

__device__ __forceinline__ XcdBarrier xcd_barrier_post(unsigned* bar, volatile LAS unsigned* st) {
    XcdBarrier b; b.bar = bar; b.x = xb_xcc_id(); b.st = st;
    if (threadIdx.x == 0) (void)xb_add(&bar[XB_XCNT(b.x)], 1u);
    return b;
}
__device__ __forceinline__ void xcd_barrier_complete(unsigned* bar, unsigned x, unsigned& nloc, unsigned& nx) {
    const unsigned G = gridDim.x * gridDim.y * gridDim.z;
    unsigned sum, cnt, mine, sp = 0u;
    for (;;) {
        sum = 0u; cnt = 0u; mine = 0u;
#pragma unroll
        for (unsigned j = 0; j < 16; ++j) { const unsigned c = xb_ld(&bar[XB_XCNT(j)]); sum += c; cnt += (c > 0u) ? 1u : 0u; mine = (j == x) ? c : mine; }
        if (sum == G) break;
        __builtin_amdgcn_s_sleep(1);
        if ((++sp & 255u) == 0u) { if (xb_ld(&bar[XB_TMO])) break; if (sp > XB_SPIN_CAP) { atomicAdd(&bar[XB_TMO], 1u); break; } }
    }
    nloc = mine > 0u ? mine : 1u; nx = cnt > 0u ? cnt : 1u;
}

__device__ __forceinline__ void xcd_barrier(const XcdBarrier& b) {
    asm volatile("s_waitcnt vmcnt(0)" ::: "memory");
    __syncthreads();
    if (threadIdx.x == 0) {
        unsigned* bar = b.bar;
        __builtin_amdgcn_s_waitcnt(0);
        unsigned nloc = b.st[0], nx = b.st[1];
        if (nloc == 0u) { xcd_barrier_complete(bar, b.x, nloc, nx); b.st[0] = nloc; b.st[1] = nx; }
        const unsigned old = xb_add(&bar[XB_XSUB(b.x)], 1u);
        const unsigned gen = old / nloc;
        if (old + 1u == (gen + 1u) * nloc) {
            __builtin_amdgcn_fence(__ATOMIC_RELEASE, "agent");
            asm volatile("s_waitcnt vmcnt(0)" ::: "memory");
            const unsigned og = xb_add(&bar[XB_TOP], 1u);
            const unsigned tg = og / nx;
            if (og + 1u == (tg + 1u) * nx) xb_add(&bar[XB_TOPGEN], 1u);
            else XB_SPIN(xb_ld(&bar[XB_TOPGEN]) == tg, bar);
            __builtin_amdgcn_fence(__ATOMIC_ACQUIRE, "agent");
            xb_add(&bar[XB_XGEN(b.x)], 1u);
            asm volatile("s_waitcnt vmcnt(0)" ::: "memory");
        } else {
            XB_SPIN(xb_ld(&bar[XB_XGEN(b.x)]) == gen, bar);
            __builtin_amdgcn_fence(__ATOMIC_ACQUIRE, "agent");
            asm volatile("s_waitcnt vmcnt(0)" ::: "memory");
        }
    }
    __syncthreads();
}

struct Params { const float* in[29]; float* out; unsigned char* ws; };

enum { I_X = 0, I_C, I_WADA, I_BADA, I_N1G, I_N2G, I_WIN, I_QG, I_KG, I_LQ1, I_LK1, I_LQ2, I_LK2, I_SUBG, I_ARE, I_AIM, I_LOGDT, I_BRE, I_BIM, I_CRE, I_CIM, I_SD,
       I_WGLU, I_BGLU, I_WOUT, I_WUP, I_CONVW, I_CONVB, I_WDN };

__device__ __forceinline__ int opaque_tid() { int t = threadIdx.x; asm volatile("" : "+v"(t)); return t; }
__device__ __forceinline__ float wave_sum(float v) {
#pragma unroll
    for (int o = 1; o < 64; o <<= 1) v += __shfl_xor(v, o);
    return v;
}
__device__ __forceinline__ unsigned f2bf(float f) { unsigned u = __builtin_bit_cast(unsigned, f); return (u + 0x7fffu + ((u >> 16) & 1u)) >> 16; }
__device__ __forceinline__ unsigned pk2(float lo, float hi) { return f2bf(lo) | (f2bf(hi) << 16); }
__device__ __forceinline__ float bf2f(unsigned short h) { return __builtin_bit_cast(float, (unsigned)h << 16); }
__device__ __forceinline__ float bflo(unsigned w) { return __builtin_bit_cast(float, w << 16); }
__device__ __forceinline__ float bfhi(unsigned w) { return __builtin_bit_cast(float, w & 0xffff0000u); }
__device__ __forceinline__ float gelu_tanh(float x) {
    const float u = 0.7978845608028654f * (x + 0.044715f * x * x * x);
    return x * __builtin_amdgcn_rcpf(1.0f + __builtin_amdgcn_exp2f(-2.0f * LOG2E * u));
}
__device__ __forceinline__ float sigmoidf_(float z) { return 1.0f * __builtin_amdgcn_rcpf(1.0f + __builtin_amdgcn_exp2f(-LOG2E * z)); }

__device__ __forceinline__ void transpose_tile(const float* __restrict__ W, int N, bf16_t* __restrict__ WT, int ldt, int k0, int n0, int drow0, LAS float* tile, int tid, int drow1 = -1) {
#pragma unroll
    for (int ps = 0; ps < 2; ++ps) {
        const int kk = ps * 32 + (tid >> 4), nn = (tid & 15) * 4;
        const f32x4 v = *(const f32x4*)(W + (size_t)(k0 + kk) * N + n0 + nn);
        tile[kk * 65 + nn + 0] = v.x; tile[kk * 65 + nn + 1] = v.y; tile[kk * 65 + nn + 2] = v.z; tile[kk * 65 + nn + 3] = v.w;
    }
    __syncthreads();
    const int n = tid >> 3, kc = tid & 7;
    u32x4 o;
    o.x = pk2(tile[(8 * kc + 0) * 65 + n], tile[(8 * kc + 1) * 65 + n]);
    o.y = pk2(tile[(8 * kc + 2) * 65 + n], tile[(8 * kc + 3) * 65 + n]);
    o.z = pk2(tile[(8 * kc + 4) * 65 + n], tile[(8 * kc + 5) * 65 + n]);
    o.w = pk2(tile[(8 * kc + 6) * 65 + n], tile[(8 * kc + 7) * 65 + n]);
    const int drow = (drow1 >= 0 && n >= 32) ? drow1 + (n - 32) : drow0 + n;
    *(u32x4*)(WT + (size_t)drow * ldt + k0 + 8 * kc) = o;
    __syncthreads();
}


__device__ __forceinline__ void transpose_tile_w(const float* __restrict__ W, int N, bf16_t* __restrict__ WT, int ldt, int k0, int n0, int drow0, int drow1, LAS float* wt, int lane) {
    const int rr = lane >> 4, c4 = (lane & 15) * 4;
#pragma unroll
    for (int hf = 0; hf < 2; ++hf) {
        f32x4 v[8];
#pragma unroll
        for (int j = 0; j < 8; ++j) v[j] = __builtin_nontemporal_load((const f32x4*)(W + (size_t)(k0 + (hf * 8 + j) * 4 + rr) * N + n0 + c4));
#pragma unroll
        for (int j = 0; j < 8; ++j) { LAS float* p = wt + ((hf * 8 + j) * 4 + rr) * 65 + c4; p[0] = v[j].x; p[1] = v[j].y; p[2] = v[j].z; p[3] = v[j].w; }
    }
    asm volatile("s_waitcnt lgkmcnt(0)" ::: "memory");
#pragma unroll
    for (int o = 0; o < 8; ++o) {
        const int idx = o * 64 + lane, n = idx >> 3, kc = idx & 7; const LAS float* p = wt + (8 * kc) * 65 + n;
        u32x4 w; w.x = pk2(p[0], p[65]); w.y = pk2(p[2 * 65], p[3 * 65]); w.z = pk2(p[4 * 65], p[5 * 65]); w.w = pk2(p[6 * 65], p[7 * 65]);
        const int drow = (drow1 >= 0 && n >= 32) ? drow1 + (n - 32) : drow0 + n;
        *(u32x4*)(WT + (size_t)drow * ldt + k0 + 8 * kc) = w;
    }
    asm volatile("s_waitcnt lgkmcnt(0)" ::: "memory");
}
constexpr int CT_WIN = 32 * 64, CT_GLU = 16 * 16, CT_OUT = 32 * 32, CT_UP = 32 * 176, CT_DN = 88 * 32;
__device__ __forceinline__ void convert_tile_w(const Params& P, int which, int r, LAS float* wt, int lane) {
    unsigned char* ws = P.ws;
    if (which == 0) { const int kb = r / 64, n0 = (r % 64) * 64;
        if (n0 >= 2048 && n0 < 3072) { transpose_tile_w(P.in[I_WIN], 4096, (bf16_t*)(ws + WS_WIN), 2048, kb * 64, n0, 3072 + (n0 - 2048), -1, wt, lane); return; }
        const int lq = n0 < 2048 ? n0 : 2048 + (n0 - 3072), tb = lq & ~255, wcg = (lq & 255) >> 6;
        transpose_tile_w(P.in[I_WIN], 4096, (bf16_t*)(ws + WS_WIN), 2048, kb * 64, n0, tb + 32 * wcg, tb + 128 + 32 * wcg, wt, lane); return; }
    if (which == 1) { transpose_tile_w(P.in[I_WGLU], 1024, (bf16_t*)(ws + WS_WGLU), 1024, (r / 16) * 64, (r % 16) * 64, (r % 16) * 64, -1, wt, lane); return; }
    if (which == 2) { transpose_tile_w(P.in[I_WOUT], 2048, (bf16_t*)(ws + WS_WOUT), 2048, (r / 32) * 64, (r % 32) * 64, (r % 32) * 64, -1, wt, lane); return; }
    if (which == 3) { const int n0 = (r % 176) * 64, isg = n0 >= DFF, f0 = n0 - isg * DFF;
        transpose_tile_w(P.in[I_WUP], 11264, (bf16_t*)(ws + WS_WUP), 2048, (r / 176) * 64, n0, (f0 >> 7) * 256 + isg * 128 + (f0 & 127), -1, wt, lane); return; }
    transpose_tile_w(P.in[I_WDN], 2048, (bf16_t*)(ws + WS_WDN), 5632, (r / 32) * 64, (r % 32) * 64, (r % 32) * 64, -1, wt, lane);
}

__device__ __forceinline__ void gemv_job(const Params& P, int job, LAS float* red, int tid) {
    const int c4 = tid & 15, rsub = tid >> 4;
    const float* cvec = P.in[I_C];
    const f32x4* W4 = (const f32x4*)P.in[I_WADA] + job * 16 + c4;
    f32x4 a0 = {0.f, 0.f, 0.f, 0.f}, a1 = {0.f, 0.f, 0.f, 0.f};
#pragma unroll 8
    for (int i = 0; i < 64; ++i) {
        const int k = i * 32 + rsub;
        const f32x4 w = __builtin_nontemporal_load(W4 + (size_t)k * 3072);
        const float c0 = cvec[k], c1 = cvec[2048 + k];
        const float s0 = c0 * sigmoidf_(c0), s1 = c1 * sigmoidf_(c1);
        a0 += w * s0; a1 += w * s1;
    }
    LAS f32x4* red4 = (LAS f32x4*)red;
    red4[(rsub * 2 + 0) * 16 + c4] = a0; red4[(rsub * 2 + 1) * 16 + c4] = a1;
    __syncthreads();
    if (tid < 32) {
        const int b = tid >> 4, c = tid & 15;
        f32x4 s = {0.f, 0.f, 0.f, 0.f};
#pragma unroll 8
        for (int r = 0; r < 32; ++r) s += red4[(r * 2 + b) * 16 + c];
        const int col = (job * 16 + c) * 4;
        s += *(const f32x4*)(P.in[I_BADA] + col);
        *(f32x4*)((float*)(P.ws + WS_MOD) + b * 12288 + col) = s;
    }
    __syncthreads();
}

__device__ __forceinline__ void norm_mod_store(const f32x4 (&v)[8], const float* g, const float* shift, const float* scale, bf16_t* orow, int lane) {
    float ss = 0.f;
#pragma unroll
    for (int j = 0; j < 8; ++j) ss += (v[j].x * v[j].x + v[j].y * v[j].y) + (v[j].z * v[j].z + v[j].w * v[j].w);
    ss = wave_sum(ss);
    const float rs = rsqrtf(ss * (1.0f / 2048.0f) + EPS);
#pragma unroll
    for (int j = 0; j < 8; ++j) {
        const int col = 4 * (lane + 64 * j);
        const f32x4 g4 = *(const f32x4*)(g + col), sh = *(const f32x4*)(shift + col), sc = *(const f32x4*)(scale + col);
        const f32x4 h = (v[j] * rs * g4) * (sc + 1.0f) + sh;
        u32x2 o; o.x = pk2(h.x, h.y); o.y = pk2(h.z, h.w);
        *(u32x2*)(orow + col) = o;
    }
}

__device__ __forceinline__ void ssm_abar(const Params& P, int g, int p, float& abr, float& abi, float& cr, float& ci) {
    const float dt = expf(P.in[I_LOGDT][g]);
    const float ar = P.in[I_ARE][g * 64 + p], ai = P.in[I_AIM][g * 64 + p];
    const float mag = expf(dt * ar); abr = mag * cosf(dt * ai); abi = mag * sinf(dt * ai);
    const float den = ar * ar + ai * ai, nr = abr - 1.0f, ni = abi;
    cr = (nr * ar + ni * ai) / den; ci = (ni * ar - nr * ai) / den;
}
__device__ __forceinline__ void ssm_tables_job(const Params& P, int g, LAS float* L, int tid) {
    LAS float* pwr = L;
    LAS float* pwi = L + 17 * 64;
    LAS float* bbr = L + 34 * 64;
    LAS float* bbi = bbr + 1024;
    LAS float* ccr = bbi + 1024;
    LAS float* cci = ccr + 1024;
    LAS float* kk = cci + 1024;
    if (tid < 64) {
        const int p = tid; float abr, abi, cr, ci; ssm_abar(P, g, p, abr, abi, cr, ci);
        float xr = 1.f, xi = 0.f;
        for (int n = 0; n <= 16; ++n) { pwr[n * 64 + p] = xr; pwi[n * 64 + p] = xi; const float nr = xr * abr - xi * abi, ni = xr * abi + xi * abr; xr = nr; xi = ni; }
        for (int c = 0; c < 16; ++c) { const float br = P.in[I_BRE][(g * 64 + p) * 16 + c], bi = P.in[I_BIM][(g * 64 + p) * 16 + c]; bbr[p * 16 + c] = cr * br - ci * bi; bbi[p * 16 + c] = cr * bi + ci * br; }
    }
    for (int i = tid; i < 1024; i += NTHREADS) { ccr[i] = P.in[I_CRE][g * 1024 + i]; cci[i] = P.in[I_CIM][g * 1024 + i]; }
    __syncthreads();
    {
        const int pair = tid & 255, c = pair >> 4, c2 = pair & 15, th = tid >> 8;
        float acc[8];
#pragma unroll
        for (int j = 0; j < 8; ++j) acc[j] = 0.f;
        for (int p = 0; p < 64; ++p) {
            const float cr_ = ccr[c * 64 + p], ci_ = cci[c * 64 + p], br = bbr[p * 16 + c2], bi = bbi[p * 16 + c2];
            const float mr = cr_ * br - ci_ * bi, mi = cr_ * bi + ci_ * br;
#pragma unroll
            for (int j = 0; j < 8; ++j) { const int tau = th * 8 + j; acc[j] += mr * pwr[tau * 64 + p] - mi * pwi[tau * 64 + p]; }
        }
#pragma unroll
        for (int j = 0; j < 8; ++j) kk[(th * 8 + j) * 256 + c * 16 + c2] = acc[j];
    }
    __syncthreads();
    bf16_t* AM = (bf16_t*)(P.ws + WS_AMAT) + (size_t)g * 256 * 384;
    for (int ch = tid; ch < 256 * 48; ch += NTHREADS) {
        const int col = ch / 48, k0 = (ch % 48) * 8, t = col >> 4, c = col & 15; float v[8];
        if (k0 < 256) { const int sidx = k0 >> 4, c2 = k0 & 15;
#pragma unroll
            for (int e = 0; e < 8; ++e) v[e] = (sidx <= t) ? kk[(t - sidx) * 256 + c * 16 + c2 + e] : 0.f;
        } else if (k0 < 320) { const int p0 = k0 - 256;
#pragma unroll
            for (int e = 0; e < 8; ++e) v[e] = ccr[c * 64 + p0 + e] * pwr[(t + 1) * 64 + p0 + e] - cci[c * 64 + p0 + e] * pwi[(t + 1) * 64 + p0 + e];
        } else { const int p0 = k0 - 320;
#pragma unroll
            for (int e = 0; e < 8; ++e) v[e] = -(ccr[c * 64 + p0 + e] * pwi[(t + 1) * 64 + p0 + e] + cci[c * 64 + p0 + e] * pwr[(t + 1) * 64 + p0 + e]);
        }
        u32x4 o; o.x = pk2(v[0], v[1]); o.y = pk2(v[2], v[3]); o.z = pk2(v[4], v[5]); o.w = pk2(v[6], v[7]);
        *(u32x4*)(AM + (size_t)col * 384 + k0) = o;
    }
    bf16_t* WM = (bf16_t*)(P.ws + WS_WMAT) + (size_t)g * 256 * 256;
    for (int ch = tid; ch < 256 * 32; ch += NTHREADS) {
        const int row = ch >> 5, k0 = (ch & 31) * 8, sidx = k0 >> 4, c2 = k0 & 15; float v[8];
#pragma unroll
        for (int e = 0; e < 8; ++e) v[e] = 0.f;
        if (row < 128) { const int p = row & 63; const float wr_ = pwr[(15 - sidx) * 64 + p], wi_ = pwi[(15 - sidx) * 64 + p];
#pragma unroll
            for (int e = 0; e < 8; ++e) { const float br = bbr[p * 16 + c2 + e], bi = bbi[p * 16 + c2 + e]; v[e] = (row < 64) ? (wr_ * br - wi_ * bi) : (wr_ * bi + wi_ * br); } }
        u32x4 o; o.x = pk2(v[0], v[1]); o.y = pk2(v[2], v[3]); o.z = pk2(v[4], v[5]); o.w = pk2(v[6], v[7]);
        *(u32x4*)(WM + (size_t)row * 256 + k0) = o;
    }
    __syncthreads();
}
__device__ __forceinline__ void ssm_carry_job(const Params& P, int g, int b, LAS float* L, int tid) {
    const int p = tid & 63, seg = tid >> 6;
    float abr, abi, cr, ci; ssm_abar(P, g, p, abr, abi, cr, ci);
    float a16r = abr, a16i = abi;
#pragma unroll
    for (int i = 0; i < 4; ++i) { const float nr = a16r * a16r - a16i * a16i, ni = 2.f * a16r * a16i; a16r = nr; a16i = ni; }
    float a512r = a16r, a512i = a16i;
#pragma unroll
    for (int i = 0; i < 5; ++i) { const float nr = a512r * a512r - a512i * a512i, ni = 2.f * a512r * a512i; a512r = nr; a512i = ni; }
    const float* S = (const float*)(P.ws + WS_SBUF) + ((size_t)g * 512 + b * 256 + seg * 32) * 128 + p;
    float xr = 0.f, xi = 0.f;
#pragma unroll 8
    for (int jj = 0; jj < 32; ++jj) { const float sr = S[jj * 128], si = S[jj * 128 + 64]; const float nr = a16r * xr - a16i * xi + sr, ni = a16r * xi + a16i * xr + si; xr = nr; xi = ni; }
    L[seg * 128 + p] = xr; L[seg * 128 + 64 + p] = xi;
    __syncthreads();
    float c0r = 0.f, c0i = 0.f;
    for (int q = 0; q < seg; ++q) { const float er = L[q * 128 + p], ei = L[q * 128 + 64 + p]; const float nr = a512r * c0r - a512i * c0i + er, ni = a512r * c0i + a512i * c0r + ei; c0r = nr; c0i = ni; }
    bf16_t* X = (bf16_t*)(P.ws + WS_UX) + ((size_t)g * 512 + b * 256 + seg * 32) * 384 + 256 + p;
    xr = c0r; xi = c0i;
#pragma unroll 8
    for (int jj = 0; jj < 32; ++jj) {
        X[(size_t)jj * 384] = (bf16_t)f2bf(xr); X[(size_t)jj * 384 + 64] = (bf16_t)f2bf(xi);
        const float sr = S[jj * 128], si = S[jj * 128 + 64]; const float nr = a16r * xr - a16i * xi + sr, ni = a16r * xi + a16i * xr + si; xr = nr; xi = ni;
    }
    __syncthreads();
}

typedef float f32x16 __attribute__((ext_vector_type(16)));
typedef short bf16x8v __attribute__((ext_vector_type(8)));
typedef short s16x4v __attribute__((ext_vector_type(4)));
typedef float f32x2v __attribute__((ext_vector_type(2)));
typedef __bf16 bf16x2v __attribute__((ext_vector_type(2)));
__device__ __forceinline__ unsigned cvtpk(float lo, float hi) { f32x2v v = {lo, hi}; bf16x2v b = __builtin_convertvector(v, bf16x2v); return __builtin_bit_cast(unsigned, b); }
constexpr int AT_KP = 144, AT_VP = 144, AT_K1 = 0, AT_K2 = 64 * AT_KP, AT_V = 2 * 64 * AT_KP, AT_STAGE = AT_V + 128 * AT_VP;

__device__ __forceinline__ void attn_unit(const Params& P, LAS unsigned char* lds, int b, int h, int qb, float lam, float wnd2b, int tid) {
    const int lane = tid & 63, wave = __builtin_amdgcn_readfirstlane(tid >> 6), sm = wave >> 2, rb = wave & 3, l31 = lane & 31, kg = lane >> 5;
    const bf16_t* QB = (const bf16_t*)(P.ws + WS_QB); const bf16_t* KB = (const bf16_t*)(P.ws + WS_KB); const bf16_t* VT = (const bf16_t*)(P.ws + WS_VT);
    bf16_t* MIX = (bf16_t*)(P.ws + WS_MIX);
    const int q0 = qb * 128; const size_t tokb = (size_t)b * SEQ;
    const int qw0 = q0 + 32 * rb, qpos = qw0 + l31;
    bf16x8v qf[4];
    { const bf16_t* qp = QB + (tokb + qpos) * 1024 + h * 128 + sm * 64 + 8 * kg;
#pragma unroll
      for (int ks = 0; ks < 4; ++ks) qf[ks] = *(const bf16x8v*)(qp + 16 * ks); }
    const float sl2 = exp2f(-(float)(h + 1)) * LOG2E;
    float l = 0.f; const float bref = 0.5f * (wnd2b - 64.0f);
    f32x16 o[4];
#pragma unroll
    for (int vb = 0; vb < 4; ++vb)
#pragma unroll
        for (int r = 0; r < 16; ++r) o[vb][r] = 0.f;
    const int NT = 2 * (qb + 1);
    int t0 = (int)floorf(((float)(q0 - 63) - wnd2b / sl2) * (1.0f / 64.0f)) + 1; t0 = t0 < 0 ? 0 : t0;
    const int krow = tid >> 3, kch = tid & 7;
    const bf16_t* kg1 = KB + (tokb + krow) * 1024 + h * 128 + kch * 8;
    const bf16_t* vg0 = VT + (size_t)(h * 128 + krow) * NTOK + tokb + kch * 8;
    const bf16_t* vg1 = vg0 + (size_t)64 * NTOK;
    const int kofs = krow * AT_KP + kch * 16, vofs0 = AT_V + krow * AT_VP + ((kch >> 1) * 16 + (kch & 1) * 4) * 2, vofs1 = vofs0 + 64 * AT_VP;
    u32x4 rk1, rk2, rv0, rv1;
#define AT_LOAD(t) do { const bf16_t* kp_ = kg1 + (size_t)(t) * 64 * 1024; rk1 = *(const u32x4*)kp_; rk2 = *(const u32x4*)(kp_ + 64); rv0 = *(const u32x4*)(vg0 + (t) * 64); rv1 = *(const u32x4*)(vg1 + (t) * 64); } while (0)
#define AT_STORE(base) do { *(LAS u32x4*)((base) + AT_K1 + kofs) = rk1; *(LAS u32x4*)((base) + AT_K2 + kofs) = rk2; \
        *(LAS u32x2*)((base) + vofs0) = (u32x2){rv0.x, rv0.y}; *(LAS u32x2*)((base) + vofs0 + 16) = (u32x2){rv0.z, rv0.w}; \
        *(LAS u32x2*)((base) + vofs1) = (u32x2){rv1.x, rv1.y}; *(LAS u32x2*)((base) + vofs1 + 16) = (u32x2){rv1.z, rv1.w}; } while (0)
    AT_LOAD(t0); AT_STORE(lds + (t0 & 1) * AT_STAGE); __syncthreads();
    for (int t = t0; t < NT; ++t) {
        LAS unsigned char* cur = lds + (t & 1) * AT_STAGE; LAS unsigned char* nxt = lds + ((t + 1) & 1) * AT_STAGE;
        if (t + 1 < NT) AT_LOAD(t + 1);
        const int kv0 = t * 64;
        if (kv0 <= qw0 + 31) {
            f32x16 p0, p1;
            { const float cbase = sl2 * (float)(kv0 + 4 * kg - qpos) - bref, s32 = 32.f * sl2;
#pragma unroll
              for (int r = 0; r < 16; ++r) { p0[r] = cbase + sl2 * (float)((r & 3) + 8 * (r >> 2)); p1[r] = p0[r] + s32; } }
            const LAS unsigned char* kb = cur + (sm ? AT_K2 : AT_K1) + l31 * AT_KP + kg * 16;
            __builtin_amdgcn_s_setprio(1);
#pragma unroll
            for (int ks = 0; ks < 4; ++ks) {
                const bf16x8v a0 = *(const LAS bf16x8v*)(kb + ks * 32), a1 = *(const LAS bf16x8v*)(kb + 32 * AT_KP + ks * 32);
                p0 = __builtin_amdgcn_mfma_f32_32x32x16_bf16(a0, qf[ks], p0, 0, 0, 0);
                p1 = __builtin_amdgcn_mfma_f32_32x32x16_bf16(a1, qf[ks], p1, 0, 0, 0);
            }
            __builtin_amdgcn_s_setprio(0);
            if (kv0 + 63 > qw0) {
                const int kb0 = kv0 + 4 * kg;
#pragma unroll
                for (int r = 0; r < 16; ++r) { const int kvp = kb0 + (r & 3) + 8 * (r >> 2); if (kvp > qpos) p0[r] = -INFINITY; if (kvp + 32 > qpos) p1[r] = -INFINITY; }
            }
            float ps = 0.f;
#pragma unroll
            for (int r = 0; r < 16; ++r) { p0[r] = __builtin_amdgcn_exp2f(p0[r]); p1[r] = __builtin_amdgcn_exp2f(p1[r]); ps += p0[r] + p1[r]; }
            l += ps;
            bf16x8v pb[4];
            { u32x4 w;
              w.x = cvtpk(p0[0], p0[1]); w.y = cvtpk(p0[2], p0[3]); w.z = cvtpk(p0[4], p0[5]); w.w = cvtpk(p0[6], p0[7]); pb[0] = __builtin_bit_cast(bf16x8v, w);
              w.x = cvtpk(p0[8], p0[9]); w.y = cvtpk(p0[10], p0[11]); w.z = cvtpk(p0[12], p0[13]); w.w = cvtpk(p0[14], p0[15]); pb[1] = __builtin_bit_cast(bf16x8v, w);
              w.x = cvtpk(p1[0], p1[1]); w.y = cvtpk(p1[2], p1[3]); w.z = cvtpk(p1[4], p1[5]); w.w = cvtpk(p1[6], p1[7]); pb[2] = __builtin_bit_cast(bf16x8v, w);
              w.x = cvtpk(p1[8], p1[9]); w.y = cvtpk(p1[10], p1[11]); w.z = cvtpk(p1[12], p1[13]); w.w = cvtpk(p1[14], p1[15]); pb[3] = __builtin_bit_cast(bf16x8v, w); }
            const LAS unsigned char* vbp = cur + AT_V + l31 * AT_VP + kg * 16;
            __builtin_amdgcn_s_setprio(1);
#pragma unroll
            for (int vb = 0; vb < 4; ++vb)
#pragma unroll
                for (int k2 = 0; k2 < 4; ++k2) {
                    const bf16x8v av = *(const LAS bf16x8v*)(vbp + vb * 32 * AT_VP + k2 * 32);
                    o[vb] = __builtin_amdgcn_mfma_f32_32x32x16_bf16(av, pb[k2], o[vb], 0, 0, 0);
                }
            __builtin_amdgcn_s_setprio(0);
        }
        if (t + 1 < NT) AT_STORE(nxt);
        __syncthreads();
    }
#undef AT_LOAD
#undef AT_STORE
    const float inv = 1.0f / (l + __shfl_xor(l, 32));
    LAS float* ob = (LAS float*)lds;
    if (sm == 1) {
#pragma unroll
        for (int vb = 0; vb < 4; ++vb)
#pragma unroll
            for (int r = 0; r < 16; ++r) ob[((rb * 4 + vb) * 16 + r) * 64 + lane] = o[vb][r] * inv;
    }
    __syncthreads();
    if (sm == 0) {
        float ss = 0.f;
#pragma unroll
        for (int vb = 0; vb < 4; ++vb)
#pragma unroll
            for (int r = 0; r < 16; ++r) { const float d = o[vb][r] * inv - lam * ob[((rb * 4 + vb) * 16 + r) * 64 + lane]; o[vb][r] = d; ss += d * d; }
        ss += __shfl_xor(ss, 32);
        const float rn = rsqrtf(ss * (1.0f / 128.0f) + EPS) * 0.8f;
        const float* gs = P.in[I_SUBG];
        bf16_t* mp = MIX + (tokb + qpos) * 2048 + h * 128;
#pragma unroll
        for (int vb = 0; vb < 4; ++vb)
#pragma unroll
            for (int r4 = 0; r4 < 4; ++r4) {
                const int vc = 32 * vb + 8 * r4 + 4 * kg; const f32x4 g4 = *(const f32x4*)(gs + vc);
                u32x2 w; w.x = cvtpk(o[vb][4 * r4 + 0] * rn * g4.x, o[vb][4 * r4 + 1] * rn * g4.y); w.y = cvtpk(o[vb][4 * r4 + 2] * rn * g4.z, o[vb][4 * r4 + 3] * rn * g4.w);
                *(u32x2*)(mp + vc) = w;
            }
    }
    __syncthreads();
}

constexpr int LATE_SPLIT = 288;
#define LATE_W_ITEM(done_, cw_, lo_, hi_) do { \
        constexpr int J_OUT_ = 32 * 32, J_UP_ = 32 * 176, J_LATE_ = J_OUT_ + J_UP_;     \
        const int tid_ = opaque_tid(); \
        if (tid_ == 0) lctl[3] = __hip_atomic_fetch_add(ctl + 64 * (cw_), 1u, __ATOMIC_RELAXED, __HIP_MEMORY_SCOPE_AGENT); \
        __syncthreads(); \
        const int it_ = (lo_) + __builtin_amdgcn_readfirstlane((int)lctl[3]); \
        __syncthreads(); \
        if (it_ >= (hi_) || it_ * 16 >= J_LATE_) { done_ = true; break; } \
        { const int w_ = __builtin_amdgcn_readfirstlane(tid_ >> 6), ln_ = tid_ & 63; \
          for (int q_ = 0; q_ < 2; ++q_) { const int r_ = it_ * 16 + q_ * 8 + w_; if (r_ < J_LATE_) { if (r_ < J_OUT_) convert_tile_w(P, 2, r_, ldsf + w_ * (64 * 65), ln_); else convert_tile_w(P, 3, r_ - J_OUT_, ldsf + w_ * (64 * 65), ln_); } } } \
        __syncthreads(); } while (0)

#define WDN_QUEUE() do { for (;;) { const int tid_ = opaque_tid(); \
        if (tid_ == 0) lctl[3] = __hip_atomic_fetch_add(ctl + 64 * 13, 1u, __ATOMIC_RELAXED, __HIP_MEMORY_SCOPE_AGENT); \
        __syncthreads(); \
        const int it_ = __builtin_amdgcn_readfirstlane((int)lctl[3]); \
        __syncthreads(); \
        if (it_ * 8 >= 88 * 32) break; \
        { const int w_ = __builtin_amdgcn_readfirstlane(tid_ >> 6); convert_tile_w(P, 4, it_ * 8 + w_, ldsf + w_ * (64 * 65), tid_ & 63); } __syncthreads(); } } while (0)

__global__ void __launch_bounds__(NTHREADS, 2) fwd_kernel(Params P) {
    extern __shared__ __attribute__((aligned(16))) unsigned char lds_raw[];
    cg::grid_group grid = cg::this_grid();
    LAS unsigned char* lds = (LAS unsigned char*)lds_raw;
    LAS float* ldsf = (LAS float*)lds_raw;
    const int tid = threadIdx.x, lane = tid & 63, wave = __builtin_amdgcn_readfirstlane(tid >> 6);
    const int G = gridDim.x, bid = blockIdx.x;
    unsigned* ctl = (unsigned*)(P.ws + WS_CTL);
    LAS unsigned* lctl = (LAS unsigned*)(lds_raw + LDS_BYTES - 256);
    if (tid == 0) { lctl[4] = 0u; lctl[5] = 0u; }
    if (bid == 0) {
        u32x4* z = (u32x4*)ctl;
        for (int i = tid; i < 65536 / 16; i += NTHREADS) z[i] = (u32x4){0u, 0u, 0u, 0u};
        asm volatile("s_waitcnt vmcnt(0)" ::: "memory");
    }
    __syncthreads();
    grid.sync();
    XcdBarrier xbar = xcd_barrier_post(ctl + 4096, (volatile LAS unsigned*)(lctl + 4));
    if (tid == 0) { const unsigned x = ((unsigned)__builtin_amdgcn_s_getreg((3 << 11) | 20)) & 7u; lctl[0] = x; lctl[1] = __hip_atomic_fetch_add(ctl + 64 * x, 1u, __ATOMIC_RELAXED, __HIP_MEMORY_SCOPE_AGENT); }
    __syncthreads();
    const int vx = __builtin_amdgcn_readfirstlane((int)lctl[0]), rank = __builtin_amdgcn_readfirstlane((int)lctl[1]);
    unsigned char* ws = P.ws;
    bf16_t* WUP = (bf16_t*)(ws + WS_WUP); bf16_t* WDN = (bf16_t*)(ws + WS_WDN); float* X1 = (float*)(ws + WS_X1); bf16_t* HB = (bf16_t*)(ws + WS_HB);
    bf16_t* APRE = (bf16_t*)(ws + WS_APRE); bf16_t* WIN = (bf16_t*)(ws + WS_WIN); bf16_t* WGLU = (bf16_t*)(ws + WS_WGLU); bf16_t* WOUT = (bf16_t*)(ws + WS_WOUT);
    bf16_t* QB = (bf16_t*)(ws + WS_QB); bf16_t* KB = (bf16_t*)(ws + WS_KB); bf16_t* VT = (bf16_t*)(ws + WS_VT); bf16_t* UX = (bf16_t*)(ws + WS_UX);
    bf16_t* MIX = (bf16_t*)(ws + WS_MIX); bf16_t* YG = (bf16_t*)(ws + WS_YG);
    const float* MOD = (const float*)(ws + WS_MOD);

    {
        const int tid = opaque_tid(), lane = tid & 63, wave = __builtin_amdgcn_readfirstlane(tid >> 6); const int lw = rank * NWAVES + wave, lt = rank * NTHREADS + tid; (void)lane; (void)lw; (void)lt;
        constexpr int J_GEMV = 192, J_T8 = (CT_WIN + CT_GLU) / 8;
        constexpr int J_TOTAL = 64 + J_GEMV + J_T8;
        const bool split = G >= 128;
        for (int k_ = 0; ; ++k_) {
            int job;
            if (!split) job = bid + k_ * G;
            else if (bid < 64) { if (k_ > 0) break; job = bid; }
            else job = 64 + (bid - 64) + k_ * (G - 64);
            if (job >= J_TOTAL) break;
            int r = job;
            if (r < 64) { ssm_tables_job(P, r, ldsf, tid); continue; } r -= 64;
            if (r < J_GEMV) { gemv_job(P, r, ldsf, tid); continue; } r -= J_GEMV;
            const int tl = r * 8 + wave;
            if (tl < CT_WIN) convert_tile_w(P, 0, tl, ldsf + wave * (64 * 65), lane); else convert_tile_w(P, 1, tl - CT_WIN, ldsf + wave * (64 * 65), lane);
        }
    }
    GRID_SYNC();
    const int nb = __builtin_amdgcn_readfirstlane((int)__hip_atomic_load(ctl + 64 * vx, __ATOMIC_RELAXED, __HIP_MEMORY_SCOPE_AGENT));
    const int NLW = nb * NWAVES, row_base = vx * 1024, NLT = nb * NTHREADS;

    { const int tid = opaque_tid(), lane = tid & 63, wave = __builtin_amdgcn_readfirstlane(tid >> 6); const int lw = rank * NWAVES + wave, lt = rank * NTHREADS + tid; (void)lane; (void)lw; (void)lt;
    for (int lr = lw; lr < 1024; lr += NLW) { const int row = row_base + lr;
        const int b = row >> 12;
        const f32x4* xr = (const f32x4*)(P.in[I_X] + (size_t)row * DM);
        f32x4 v[8];
#pragma unroll
        for (int j = 0; j < 8; ++j) v[j] = __builtin_nontemporal_load(xr + lane + 64 * j);
        norm_mod_store(v, P.in[I_N1G], MOD + b * 12288 + 0, MOD + b * 12288 + 2048, HB + (size_t)row * DM, lane);
    }
    }
    XCD_SYNC();
    {
        pg8::Gemm g{HB, WIN, NTOK, NQKU, DM, DM, DM}; pg8::XcdOrder S; S.init(NTOK, NQKU, vx, rank, nb);
        pg8::EpiQKU E{QB, KB, UX, P.in[I_QG], P.in[I_KG], C2, EPS};
        pg8::gemm_phase<pg8::EpiQKU, pg8::XcdOrder, true, true>(lds, g, S, E);
    }
    {
        pg8::Gemm g{WIN + (size_t)3072 * DM, HB, 1024, NTOK, DM, DM, DM}; pg8::VtOrder S; S.init(vx, rank, nb);
        pg8::EpiBf16<0> E{VT, NTOK, nullptr, 0, 0, 1.f};
        pg8::gemm_phase<pg8::EpiBf16<0>, pg8::VtOrder, true, true>(lds, g, S, E);
    }
    GRID_SYNC();
    for (;;) {
        const int tid = opaque_tid();
        if (tid == 0) lctl[2] = __hip_atomic_fetch_add(ctl + 64 * 9, 1u, __ATOMIC_RELAXED, __HIP_MEMORY_SCOPE_AGENT);
        __syncthreads();
        const int u0 = __builtin_amdgcn_readfirstlane((int)lctl[2]);
        __syncthreads();
        if (u0 >= 128) break;
        const int sg = u0 >> 1, sb = u0 & 1;
        { int kS = 256; asm volatile("" : "+s"(kS));
          pg8::Gemm g{UX, (const bf16_t*)(ws + WS_WMAT), 64 * 512, 256, kS, 384, 256}; pg8::OneUnit S{u0, sg}; pg8::EpiS E{(float*)(ws + WS_SBUF)};
          pg8::gemm_phase<pg8::EpiS, pg8::OneUnit, true, true>(lds, g, S, E); }
        asm volatile("s_waitcnt vmcnt(0) lgkmcnt(0)" ::: "memory"); __syncthreads();
        ssm_carry_job(P, sg, sb, ldsf, opaque_tid());
        asm volatile("s_waitcnt vmcnt(0) lgkmcnt(0)" ::: "memory"); __syncthreads();
        { int kY = 384; asm volatile("" : "+s"(kY));
          pg8::Gemm g{UX, (const bf16_t*)(ws + WS_AMAT), 64 * 512, 256, kY, 384, 384}; pg8::OneUnit S{u0, sg}; pg8::EpiY E{UX, P.in[I_SD], YG};
          pg8::gemm_phase<pg8::EpiY, pg8::OneUnit, true, true>(lds, g, S, E); }
        asm volatile("s_waitcnt vmcnt(0) lgkmcnt(0)" ::: "memory"); __syncthreads();
        if (opaque_tid() == 0) {
            __builtin_amdgcn_fence(__ATOMIC_RELEASE, "agent"); asm volatile("s_waitcnt vmcnt(0)" ::: "memory");
            __hip_atomic_fetch_add(ctl + 64 * (16 + sb), 1u, __ATOMIC_RELAXED, __HIP_MEMORY_SCOPE_AGENT); }
    }
    {
        const int tid = opaque_tid(), lane = tid & 63;
        float lam, wnd2b;
        { const float a = wave_sum(P.in[I_LQ1][lane] * P.in[I_LK1][lane]), b2 = wave_sum(P.in[I_LQ2][lane] * P.in[I_LK2][lane]); lam = expf(a) - expf(b2) + 0.2f; }
        { float gq = fabsf(P.in[I_QG][lane]), gk = fabsf(P.in[I_KG][lane]);
#pragma unroll
          for (int o_ = 1; o_ < 64; o_ <<= 1) { gq = fmaxf(gq, __shfl_xor(gq, o_)); gk = fmaxf(gk, __shfl_xor(gk, o_)); }
          wnd2b = 2.0f * (8.0f * gq * gk * LOG2E * 1.02f) + 64.0f; }
        bool late_w_done = false;
        for (;;) {
            if (tid == 0) lctl[2] = __hip_atomic_fetch_add(ctl + 64 * 10, 1u, __ATOMIC_RELAXED, __HIP_MEMORY_SCOPE_AGENT);
            __syncthreads();
            const int u = __builtin_amdgcn_readfirstlane((int)lctl[2]);
            __syncthreads();
            if (u >= BATCH * NH * 32) break;
            attn_unit(P, lds, (u & 15) >> 3, u & 7, 31 - (u >> 4), lam, wnd2b, tid);
            if (!late_w_done) LATE_W_ITEM(late_w_done, 15, 0, LATE_SPLIT);
        }
    }
    for (;;) {
        const int tid = opaque_tid();
        if (tid == 0) lctl[2] = __hip_atomic_fetch_add(ctl + 64 * 14, 1u, __ATOMIC_RELAXED, __HIP_MEMORY_SCOPE_AGENT);
        __syncthreads();
        const int t = __builtin_amdgcn_readfirstlane((int)lctl[2]);
        __syncthreads();
        if (t >= 128) break;
        const int pm = t >> 2, pn = t & 3;
        if (tid == 0) {
            while (__hip_atomic_load(ctl + 64 * (16 + (pm >> 4)), __ATOMIC_RELAXED, __HIP_MEMORY_SCOPE_AGENT) < 64u) __builtin_amdgcn_s_sleep(8);
            __builtin_amdgcn_fence(__ATOMIC_ACQUIRE, "agent"); asm volatile("s_waitcnt vmcnt(0)" ::: "memory"); }
        __syncthreads();
        { pg8::Gemm g{YG, WGLU, NTOK, 1024, 1024, 1024, 1024}; pg8::OneUnit S{pm, pn}; pg8::EpiGlu E{YG, 1024, P.in[I_BGLU], MIX + 1024, 2048};
          pg8::gemm_phase<pg8::EpiGlu, pg8::OneUnit, true, true>(lds, g, S, E); }
        asm volatile("s_waitcnt vmcnt(0) lgkmcnt(0)" ::: "memory"); __syncthreads();
    }
    { bool late_done = false;
      while (!late_done) LATE_W_ITEM(late_done, 18, LATE_SPLIT, 416);
      late_done = false; while (!late_done) LATE_W_ITEM(late_done, 15, 0, LATE_SPLIT); }
    GRID_SYNC();
    {
        pg8::Gemm g{MIX, WOUT, NTOK, DM, DM, DM, DM}; pg8::XcdOrder S; S.init(NTOK, DM, vx, rank, nb);
        pg8::EpiResOutB E{P.in[I_X], MOD + 4096, (bf16_t*)X1, DM};
        pg8::gemm_phase<pg8::EpiResOutB, pg8::XcdOrder, true, true>(lds, g, S, E);
    }
    XCD_SYNC();
    { const int tid = opaque_tid(), lane = tid & 63, wave = __builtin_amdgcn_readfirstlane(tid >> 6); const int lw = rank * NWAVES + wave, lt = rank * NTHREADS + tid; (void)lane; (void)lw; (void)lt;
    for (int lr = lw; lr < 1024; lr += NLW) { const int row = row_base + lr;
        const int b = row >> 12;
        const u32x2* x1r = (const u32x2*)((const bf16_t*)X1 + (size_t)row * DM);
        f32x4 v[8];
#pragma unroll
        for (int j = 0; j < 8; ++j) { const u32x2 q = x1r[lane + 64 * j]; v[j] = (f32x4){bflo(q.x), bfhi(q.x), bflo(q.y), bfhi(q.y)}; }
        norm_mod_store(v, P.in[I_N2G], MOD + b * 12288 + 6144, MOD + b * 12288 + 8192, HB + (size_t)row * DM, lane);
    }
    }
    XCD_SYNC();
    bf16_t* ACT = APRE;
    {
        pg8::Gemm g{HB, WUP, NTOK, 2 * DFF, DM, DM, DM}; pg8::XcdOrder S; S.init(NTOK, 2 * DFF, vx, rank, nb);
        pg8::EpiUpAct E{ACT, (bf16_t*)(ws + WS_SIDEA), (bf16_t*)(ws + WS_SIDEB), P.in[I_CONVW], P.in[I_CONVB], DFF};
        pg8::gemm_phase<pg8::EpiUpAct, pg8::XcdOrder, true, true>(lds, g, S, E);
        WDN_QUEUE();
    }
    GRID_SYNC();
    { const int tid = opaque_tid(); const int lt = rank * NTHREADS + tid;
    for (int lj = lt; lj < 16 * 704; lj += NLT) {
        const int fv = lj % 704, blk = vx * 16 + lj / 704, f0 = fv * 8, t0 = blk * 64;
        const bf16_t* sA = (const bf16_t*)(ws + WS_SIDEA); const bf16_t* sB = (const bf16_t*)(ws + WS_SIDEB) + (size_t)blk * 4 * DFF + f0;
        u32x4 pm2 = {0u, 0u, 0u, 0u}, pm1 = {0u, 0u, 0u, 0u};
        if ((t0 & 4095) != 0) { const bf16_t* p = sA + (size_t)(blk - 1) * 2 * DFF + f0; pm2 = *(const u32x4*)p; pm1 = *(const u32x4*)(p + DFF); }
        const u32x4 qa0 = *(const u32x4*)sB, qg0 = *(const u32x4*)(sB + DFF), qa1 = *(const u32x4*)(sB + 2 * DFF), qg1 = *(const u32x4*)(sB + 3 * DFF);
        float am2[8], am1[8], a0[8], g0[8], a1[8], g1[8], o0[8], o1[8];
#define UNPK(dst, V_) do { dst[0] = bflo(V_.x); dst[1] = bfhi(V_.x); dst[2] = bflo(V_.y); dst[3] = bfhi(V_.y); dst[4] = bflo(V_.z); dst[5] = bfhi(V_.z); dst[6] = bflo(V_.w); dst[7] = bfhi(V_.w); } while (0)
        UNPK(am2, pm2); UNPK(am1, pm1); UNPK(a0, qa0); UNPK(g0, qg0); UNPK(a1, qa1); UNPK(g1, qg1);
#undef UNPK
#pragma unroll
        for (int h = 0; h < 2; ++h) { const f32x4 c0 = *(const f32x4*)(P.in[I_CONVW] + f0 + 4 * h), c1 = *(const f32x4*)(P.in[I_CONVW] + DFF + f0 + 4 * h), c2 = *(const f32x4*)(P.in[I_CONVW] + 2 * DFF + f0 + 4 * h), bb = *(const f32x4*)(P.in[I_CONVB] + f0 + 4 * h);
#pragma unroll
            for (int e4 = 0; e4 < 4; ++e4) { const int e = 4 * h + e4;
                o0[e] = gelu_tanh(c0[e4] * am2[e] + c1[e4] * am1[e] + c2[e4] * a0[e] + bb[e4]) * g0[e];
                o1[e] = gelu_tanh(c0[e4] * am1[e] + c1[e4] * a0[e] + c2[e4] * a1[e] + bb[e4]) * g1[e]; } }
        u32x4 w0, w1; w0.x = pk2(o0[0], o0[1]); w0.y = pk2(o0[2], o0[3]); w0.z = pk2(o0[4], o0[5]); w0.w = pk2(o0[6], o0[7]);
        w1.x = pk2(o1[0], o1[1]); w1.y = pk2(o1[2], o1[3]); w1.z = pk2(o1[4], o1[5]); w1.w = pk2(o1[6], o1[7]);
        *(u32x4*)(ACT + (size_t)t0 * DFF + f0) = w0; *(u32x4*)(ACT + (size_t)(t0 + 1) * DFF + f0) = w1;
    }
    }
    XCD_SYNC();

    {
        pg8::Gemm g{ACT, WDN, NTOK, DM, DFF, DFF, DFF}; pg8::XcdOrder S; S.init(NTOK, DM, vx, rank, nb);
        pg8::EpiResInB E{(const bf16_t*)X1, MOD + 10240, P.out, DM};
        pg8::gemm_phase<pg8::EpiResInB, pg8::XcdOrder, true, true>(lds, g, S, E);
    }
}

extern "C" void kernel_launch(void* const* d_in, const int* in_sizes, int n_in, void* d_out, int out_size, void* d_ws, size_t ws_size, hipStream_t stream) {
    static int grid_blocks = 0;
    if (grid_blocks == 0) {
        if (n_in != 29 || ws_size < WS_END) { fprintf(stderr, "kernel_launch: unexpected n_in %d or ws_size %zu\n", n_in, ws_size); grid_blocks = -1; return; }
        int dev = 0, cus = 0, per_cu = 0;
        hipGetDevice(&dev);
        hipDeviceGetAttribute(&cus, hipDeviceAttributeMultiprocessorCount, dev);
        if (hipFuncSetAttribute((const void*)fwd_kernel, hipFuncAttributeMaxDynamicSharedMemorySize, LDS_BYTES) != hipSuccess) fprintf(stderr, "hipFuncSetAttribute failed\n");
        if (hipOccupancyMaxActiveBlocksPerMultiprocessor(&per_cu, (const void*)fwd_kernel, NTHREADS, LDS_BYTES) != hipSuccess || per_cu < 1) { fprintf(stderr, "occupancy query: %d\n", per_cu); per_cu = 1; }
        (void)hipGetLastError();
        grid_blocks = cus;
    }
    if (grid_blocks < 0) return;
    Params p{};
    for (int i = 0; i < 29; ++i) p.in[i] = (const float*)d_in[i];
    p.out = (float*)d_out; p.ws = (unsigned char*)d_ws;
    void* args[] = {&p};
    hipError_t e = hipLaunchCooperativeKernel((const void*)fwd_kernel, dim3(grid_blocks), dim3(NTHREADS), args, LDS_BYTES, stream);
    if (e != hipSuccess) fprintf(stderr, "cooperative launch failed: %s (grid %d)\n", hipGetErrorString(e), grid_blocks);
}
```

```cpp
#include <hip/hip_runtime.h>
#include <hip/hip_cooperative_groups.h>
#include <cstdio>
#include <cstdint>
namespace cg = cooperative_groups;
namespace pg8 {
#define PG8_LAS __attribute__((address_space(3)))
typedef unsigned short bf16_t;
typedef short bf16x8 __attribute__((ext_vector_type(8)));
typedef float f32x4 __attribute__((ext_vector_type(4)));
typedef unsigned u32x4 __attribute__((ext_vector_type(4)));
constexpr int BM = 256, BK = 64, HALF = 128, HTB = HALF * BK * 2  , STAGE_BYTES = 8 * HTB, NXCD = 8, WGM = 8;

__host__ __device__ __forceinline__ int lds_byte(int r, int c) { const int st = (r >> 4) * 2 + (c >> 5), rr = r & 15, cc = c & 31, ob = rr * 64 + cc * 2; return st * 1024 + (ob ^ (((ob >> 9) & 1) << 5)); }
__host__ __device__ __forceinline__ void stage_rc(int b, int& R, int& C) { const int st = b / 1024, sb = b % 1024, swz = sb ^ (((sb >> 9) & 1) << 5); R = (st >> 1) * 16 + swz / 64; C = (st & 1) * 32 + (swz % 64) / 2; }
__host__ __device__ __forceinline__ int perm32(int rho) { const int n = rho >> 4, i = rho & 15; return 8 * (i >> 2) + 4 * n + (i & 3); }

struct Unit { int pm, pn; };
struct Gemm { const bf16_t* A; const bf16_t* Bt; int M, N, K, lda, ldb; };

struct StaticOrder {
    int nM, nN, nwg, G, c;
    __host__ __device__ void init(int M, int N, int G_, int c_) { nM = M / BM; nN = N / BM; nwg = nM * nN; G = G_; c = c_; }
    __host__ __device__ bool next(int i, Unit& u) const {
        const long L = (long)i * G + c; if (L >= nwg) return false;
        int wgid = (int)L; { const int q = nwg / NXCD, r = nwg % NXCD, xcd = wgid % NXCD, off = wgid / NXCD; wgid = (xcd < r ? xcd * (q + 1) : r * (q + 1) + (xcd - r) * q) + off; }
        const int nig = WGM * nN, gid = wgid / nig, fm = gid * WGM, gsz = (nM - fm) < WGM ? (nM - fm) : WGM;
        u.pm = fm + ((wgid % nig) % gsz); u.pn = (wgid % nig) / gsz; return true;
    }
    __device__ __forceinline__ void a_ready(const Unit&) const {}
    __device__ __forceinline__ void done(const Unit&) const {}
};

__device__ __forceinline__ unsigned cvt_pk_bf16(float lo, float hi) { unsigned r; asm volatile("v_cvt_pk_bf16_f32 %0, %1, %2" : "=v"(r) : "v"(lo), "v"(hi)); return r; }
typedef float f32x2 __attribute__((ext_vector_type(2)));
__device__ __forceinline__ f32x2 gelu_pk(f32x2 v) {
    const f32x2 av = __builtin_elementwise_abs(v), d = av * 0.2316418882f + 1.0f;
    f32x2 t; t.x = __builtin_amdgcn_rcpf(d.x); t.y = __builtin_amdgcn_rcpf(d.y);
    f32x2 q = t * 0.5307027145f + (-0.7265760135f); q = q * t + 0.7107068705f; q = q * t + (-0.142248368f); q = q * t + 0.127414796f; q = q * t;
    const f32x2 s = (v * v) * (-0.72134752044f);
    f32x2 e; e.x = __builtin_amdgcn_exp2f(s.x); e.y = __builtin_amdgcn_exp2f(s.y);
    const f32x2 m = v * (q * e), r = v - m;
    f32x2 o; o.x = v.x < 0.f ? m.x : r.x; o.y = v.y < 0.f ? m.y : r.y; return o;
}

template <int ACT  > struct EpiBf16 {
    static constexpr bool PERM = true, AFTER_DRAIN = false; static_assert(ACT == 0 || ACT == 1, "EpiBf16: ACT is 0 (none) or 1 (gelu_pk)");
    bf16_t* O; int ldc; const float* bias; int split_cols; size_t split_stride; float scale0;
    __device__ __forceinline__ void operator()(const f32x4 (&acc)[2][2][4][2], const Unit& u, int wr, int wc, int fr, int fq) const {
        const int row0 = u.pm * BM + wr * 64 + fr; int colt = u.pn * BM; bf16_t* base = O;
        float sc = 1.f; if (split_cols) { const int t = colt / split_cols; base += (size_t)t * split_stride; colt -= t * split_cols; if (t == 0) sc = scale0; }
        const int col0 = colt + wc * 32 + 8 * fq, bcol0 = u.pn * BM + wc * 32 + 8 * fq;
        f32x4 bv[2][2];
#pragma unroll
        for (int bj = 0; bj < 2; ++bj)
#pragma unroll
            for (int n = 0; n < 2; ++n) bv[bj][n] = bias ? *(const f32x4*)(bias + bcol0 + bj * HALF + 4 * n) : (f32x4){0.f, 0.f, 0.f, 0.f};
#pragma unroll
        for (int ai = 0; ai < 2; ++ai)
#pragma unroll
            for (int m = 0; m < 4; ++m) { bf16_t* rowp = base + (size_t)(row0 + ai * HALF + m * 16) * ldc + col0;
#pragma unroll
                for (int bj = 0; bj < 2; ++bj) { f32x4 v0 = acc[ai][bj][m][0] + bv[bj][0], v1 = acc[ai][bj][m][1] + bv[bj][1];
                    if (ACT == 1) { f32x2 a = gelu_pk((f32x2){v0[0], v0[1]}), b = gelu_pk((f32x2){v0[2], v0[3]}), c = gelu_pk((f32x2){v1[0], v1[1]}), d = gelu_pk((f32x2){v1[2], v1[3]});
                        v0 = (f32x4){a.x, a.y, b.x, b.y}; v1 = (f32x4){c.x, c.y, d.x, d.y}; }
                    v0 = v0 * sc; v1 = v1 * sc; u32x4 w; w.x = cvt_pk_bf16(v0[0], v0[1]); w.y = cvt_pk_bf16(v0[2], v0[3]); w.z = cvt_pk_bf16(v1[0], v1[1]); w.w = cvt_pk_bf16(v1[2], v1[3]);
                    *(u32x4*)(rowp + bj * HALF) = w; } }
    }
};
template <class Epi, class Sched, bool ALIGN_EPI = false, bool SP2 = false>
__device__ __forceinline__ void gemm_phase(PG8_LAS unsigned char* lds, const Gemm g, const Sched& S, const Epi& E) {
    int tid_o = threadIdx.x; asm volatile("" : "+v"(tid_o));
    const int tid = tid_o, wid = __builtin_amdgcn_readfirstlane(tid >> 6), lane = tid & 63, wr = wid >> 2, wc = wid & 3, fr = lane & 15, fq = lane >> 4;
    const int K = g.K, nt = K / BK;
    unsigned voffA[2], voffB[2];
#pragma unroll
    for (int i = 0; i < 2; ++i) { int R, C; stage_rc(tid * 16 + i * 8192, R, C); const int Rb = Epi::PERM ? ((R & ~31) + perm32(R & 31)) : R;
        voffA[i] = (unsigned)(R * g.lda + C) * 2u; voffB[i] = (unsigned)(Rb * g.ldb + C) * 2u; }
    const size_t kstep = (size_t)(BK * 2);
    const size_t hstepA = (size_t)HALF * g.lda * 2, hstepB = (size_t)HALF * g.ldb * 2;
    const size_t tstepA = 2 * hstepA, tstepB = 2 * hstepB;
    const unsigned ldsw = (unsigned)wid * 1024u;
    const int aoff = lds_byte(wr * 64 + fr, fq * 8), boff = lds_byte(wc * 32 + fr, fq * 8);
#define PG8_SA(b, h) (((b) * 2 + (h)) * HTB)
#define PG8_SB(b, h) ((4 + (b) * 2 + (h)) * HTB)
#define PG8_STAGE(bufoff, gbase, voff) do { _Pragma("unroll") for (int _i = 0; _i < 2; ++_i) \
        __builtin_amdgcn_global_load_lds((const unsigned*)((const char*)(gbase) + (voff)[_i]), (PG8_LAS unsigned*)(lds + (bufoff) + ldsw + _i * 8192), 16, 0, 0); } while (0)
#define PG8_LDA(dst, b, h) do { _Pragma("unroll") for (int m = 0; m < 4; ++m) _Pragma("unroll") for (int k = 0; k < 2; ++k) dst[m][k] = *(const PG8_LAS bf16x8*)(lds + PG8_SA(b, h) + aoff + m * 2048 + k * 1024); } while (0)
#define PG8_LDB(dst, b, h) do { _Pragma("unroll") for (int n = 0; n < 2; ++n) _Pragma("unroll") for (int k = 0; k < 2; ++k) dst[n][k] = *(const PG8_LAS bf16x8*)(lds + PG8_SB(b, h) + boff + n * 2048 + k * 1024); } while (0)
#define PG8_MMA(ai, bj, At, Bt) do { __builtin_amdgcn_s_setprio(1); _Pragma("unroll") for (int m = 0; m < 4; ++m) _Pragma("unroll") for (int n = 0; n < 2; ++n) _Pragma("unroll") for (int k = 0; k < 2; ++k) \
        acc[ai][bj][m][n] = __builtin_amdgcn_mfma_f32_16x16x32_bf16(Bt[n][k], At[m][k], acc[ai][bj][m][n], 0, 0, 0); __builtin_amdgcn_s_setprio(0); } while (0)
#define PG8_WAIT_V(n) asm volatile("s_waitcnt vmcnt(" #n ")" ::: "memory")
#define PG8_WAIT_L(n) asm volatile("s_waitcnt lgkmcnt(" #n ")" ::: "memory")
#define PG8_BAR __builtin_amdgcn_s_barrier()
#define PG8_SCHED __builtin_amdgcn_sched_barrier(0)
    Unit cur, nxt; int ui = 0;
    if (!S.next(0, cur)) return;
    f32x4 acc[2][2][4][2];
#pragma unroll
    for (int a = 0; a < 2; ++a)
#pragma unroll
        for (int b = 0; b < 2; ++b)
#pragma unroll
            for (int m = 0; m < 4; ++m)
#pragma unroll
                for (int n = 0; n < 2; ++n) acc[a][b][m][n] = (f32x4){0.f, 0.f, 0.f, 0.f};
    bf16x8 At[4][2], B0[2][2], B1[2][2];
    const char* cA = (const char*)g.A + (size_t)cur.pm * tstepA; const char* cB = (const char*)g.Bt + (size_t)cur.pn * tstepB;
    S.a_ready(cur);
    if constexpr (SP2) {
        PG8_STAGE(PG8_SB(0, 0), cB, voffB); PG8_STAGE(PG8_SB(0, 1), cB + hstepB, voffB); PG8_STAGE(PG8_SA(0, 0), cA, voffA); PG8_STAGE(PG8_SA(0, 1), cA + hstepA, voffA);
        if (wr == 1) PG8_BAR;
        PG8_WAIT_V(2); PG8_BAR;
        PG8_STAGE(PG8_SB(1, 0), cB + kstep, voffB); PG8_STAGE(PG8_SA(1, 0), cA + kstep, voffA); PG8_STAGE(PG8_SB(1, 1), cB + hstepB + kstep, voffB);
        PG8_WAIT_V(6); PG8_BAR;
    } else {
        PG8_STAGE(PG8_SB(0, 0), cB, voffB); PG8_STAGE(PG8_SA(0, 0), cA, voffA); PG8_STAGE(PG8_SB(0, 1), cB + hstepB, voffB); PG8_STAGE(PG8_SA(0, 1), cA + hstepA, voffA);
        if (wr == 1) PG8_BAR;
        PG8_WAIT_V(4); PG8_BAR;
        PG8_STAGE(PG8_SB(1, 0), cB + kstep, voffB); PG8_STAGE(PG8_SA(1, 0), cA + kstep, voffA); PG8_STAGE(PG8_SB(1, 1), cB + hstepB + kstep, voffB);
        PG8_WAIT_V(6); PG8_BAR;
    }
    for (;;) {
        const bool has_next = S.next(ui + 1, nxt);
        const char* nA = has_next ? (const char*)g.A + (size_t)nxt.pm * tstepA : cA; const char* nB = has_next ? (const char*)g.Bt + (size_t)nxt.pn * tstepB : cB;
        for (int t = 0; t < nt; t += 2) {
            const bool last = (t == nt - 2);
            const char* a1 = cA + (size_t)(t + 1) * kstep;
            const char* a2 = last ? nA : cA + (size_t)(t + 2) * kstep; const char* b2 = last ? nB : cB + (size_t)(t + 2) * kstep;
            const char* a3 = a2 + kstep; const char* b3 = b2 + kstep;
            if (last && has_next) S.a_ready(nxt);
            if constexpr (SP2) {
            PG8_LDB(B0, 0, 0); PG8_LDB(B1, 0, 1); PG8_SCHED; PG8_LDA(At, 0, 0); PG8_STAGE(PG8_SA(1, 1), a1 + hstepA, voffA);
            PG8_WAIT_V(8); PG8_WAIT_L(0); PG8_BAR; PG8_MMA(0, 0, At, B0); PG8_MMA(0, 1, At, B1); PG8_BAR; PG8_SCHED;
            PG8_LDA(At, 0, 1); PG8_STAGE(PG8_SB(0, 0), b2, voffB); PG8_STAGE(PG8_SB(0, 1), b2 + hstepB, voffB); PG8_STAGE(PG8_SA(0, 0), a2, voffA);
            PG8_WAIT_V(8); PG8_WAIT_L(0); PG8_BAR; PG8_MMA(1, 0, At, B0); PG8_MMA(1, 1, At, B1); PG8_BAR; PG8_SCHED;
            PG8_LDB(B0, 1, 0); PG8_LDB(B1, 1, 1); PG8_SCHED; PG8_LDA(At, 1, 0); PG8_STAGE(PG8_SA(0, 1), a2 + hstepA, voffA);
            PG8_WAIT_V(8); PG8_WAIT_L(0); PG8_BAR; PG8_MMA(0, 0, At, B0); PG8_MMA(0, 1, At, B1); PG8_BAR; PG8_SCHED;
            PG8_LDA(At, 1, 1); PG8_STAGE(PG8_SB(1, 0), b3, voffB); PG8_STAGE(PG8_SB(1, 1), b3 + hstepB, voffB); PG8_STAGE(PG8_SA(1, 0), a3, voffA);
            PG8_WAIT_V(8); PG8_WAIT_L(0); PG8_BAR; PG8_MMA(1, 0, At, B0); PG8_MMA(1, 1, At, B1); PG8_BAR; PG8_SCHED;
            } else {
            PG8_LDB(B0, 0, 0); PG8_SCHED; PG8_LDA(At, 0, 0); PG8_STAGE(PG8_SA(1, 1), a1 + hstepA, voffA);
            PG8_WAIT_L(8); PG8_BAR; PG8_WAIT_L(0); PG8_MMA(0, 0, At, B0); PG8_BAR; PG8_SCHED;
            PG8_LDB(B1, 0, 1); PG8_STAGE(PG8_SB(0, 0), b2, voffB);
            PG8_BAR; PG8_WAIT_L(0); PG8_MMA(0, 1, At, B1); PG8_BAR;
            PG8_LDA(At, 0, 1); PG8_STAGE(PG8_SA(0, 0), a2, voffA);
            PG8_BAR; PG8_WAIT_L(0); PG8_MMA(1, 0, At, B0); PG8_BAR; PG8_SCHED;
            PG8_STAGE(PG8_SB(0, 1), b2 + hstepB, voffB);
            PG8_WAIT_V(6); PG8_BAR; PG8_MMA(1, 1, At, B1); PG8_BAR;
            PG8_LDB(B0, 1, 0); PG8_SCHED; PG8_LDA(At, 1, 0); PG8_STAGE(PG8_SA(0, 1), a2 + hstepA, voffA);
            PG8_WAIT_L(8); PG8_BAR; PG8_WAIT_L(0); PG8_MMA(0, 0, At, B0); PG8_BAR; PG8_SCHED;
            PG8_LDB(B1, 1, 1); PG8_STAGE(PG8_SB(1, 0), b3, voffB);
            PG8_BAR; PG8_WAIT_L(0); PG8_MMA(0, 1, At, B1); PG8_BAR;
            PG8_LDA(At, 1, 1); PG8_STAGE(PG8_SA(1, 0), a3, voffA);
            PG8_BAR; PG8_WAIT_L(0); PG8_MMA(1, 0, At, B0); PG8_BAR; PG8_SCHED;
            PG8_STAGE(PG8_SB(1, 1), b3 + hstepB, voffB);
            PG8_WAIT_V(6); PG8_BAR; PG8_MMA(1, 1, At, B1); PG8_BAR;
            }
        }
        if constexpr (ALIGN_EPI) { if (wr == 0) PG8_BAR; }
        if constexpr (!Epi::AFTER_DRAIN) { E(acc, cur, wr, wc, fr, fq); S.done(cur); }
        if (!has_next) break;
#pragma unroll
        for (int a = 0; a < 2; ++a)
#pragma unroll
            for (int b = 0; b < 2; ++b)
#pragma unroll
                for (int m = 0; m < 4; ++m)
#pragma unroll
                    for (int n = 0; n < 2; ++n) acc[a][b][m][n] = (f32x4){0.f, 0.f, 0.f, 0.f};
        cur = nxt; cA = nA; cB = nB; ++ui;
        if constexpr (ALIGN_EPI) { if (wr == 1) PG8_BAR; }
    }
    PG8_WAIT_V(0);
    if constexpr (!ALIGN_EPI) { if (wr == 0) PG8_BAR; }
    PG8_BAR;
    if constexpr (Epi::AFTER_DRAIN) { E.fused(acc, cur, wr, wc, fr, fq, lds, wid, lane); S.done(cur); }
#undef PG8_SA
#undef PG8_SB
#undef PG8_STAGE
#undef PG8_LDA
#undef PG8_LDB
#undef PG8_MMA
#undef PG8_WAIT_V
#undef PG8_WAIT_L
#undef PG8_BAR
#undef PG8_SCHED
}
}

namespace pg8 {
struct EpiF32 {
    static constexpr bool PERM = true, AFTER_DRAIN = false;
    float* O; int ldc;
    __device__ __forceinline__ void operator()(const f32x4 (&acc)[2][2][4][2], const Unit& u, int wr, int wc, int fr, int fq) const {
        const int row0 = u.pm * BM + wr * 64 + fr, col0 = u.pn * BM + wc * 32 + 8 * fq;
#pragma unroll
        for (int ai = 0; ai < 2; ++ai)
#pragma unroll
            for (int m = 0; m < 4; ++m) { float* rowp = O + (size_t)(row0 + ai * HALF + m * 16) * ldc + col0;
#pragma unroll
                for (int bj = 0; bj < 2; ++bj) { *(f32x4*)(rowp + bj * HALF) = acc[ai][bj][m][0]; *(f32x4*)(rowp + bj * HALF + 4) = acc[ai][bj][m][1]; } }
    }
};

struct XcdOrder {
    int ppx, ntile, rank, nb, pm0;
    __device__ void init(int M, int N, int vx, int rank_, int nb_) { ppx = (M / BM) / NXCD; ntile = ppx * (N / BM); rank = rank_; nb = nb_; pm0 = vx * ppx; }
    __device__ bool next(int i, Unit& u) const { const int t = rank + i * nb; if (t >= ntile) return false; u.pm = pm0 + t % ppx; u.pn = t / ppx; return true; }
    __device__ __forceinline__ void a_ready(const Unit&) const {}
    __device__ __forceinline__ void done(const Unit&) const {}
};
struct VtOrder {
    int vx, r2, nb2;
    __device__ void init(int vx_, int rank, int nb) { vx = vx_; r2 = rank - nb / 2; nb2 = nb - nb / 2; }
    __device__ bool next(int i, Unit& u) const { if (r2 < 0) return false; const int t = r2 + i * nb2; if (t >= 16) return false; u.pm = t & 3; u.pn = vx * 4 + (t >> 2); return true; }
    __device__ __forceinline__ void a_ready(const Unit&) const {}
    __device__ __forceinline__ void done(const Unit&) const {}
};
struct EpiUp {
    static constexpr bool PERM = true, AFTER_DRAIN = false;
    bf16_t* O; int ldc; bf16_t* side; int acols;
    __device__ __forceinline__ void operator()(const f32x4 (&acc)[2][2][4][2], const Unit& u, int wr, int wc, int fr, int fq) const {
        const int row0 = u.pm * BM + wr * 64 + fr, col0 = u.pn * BM + wc * 32 + 8 * fq;
#pragma unroll
        for (int ai = 0; ai < 2; ++ai)
#pragma unroll
            for (int m = 0; m < 4; ++m) { const int row = row0 + ai * HALF + m * 16; bf16_t* rowp = O + (size_t)row * ldc + col0;
#pragma unroll
                for (int bj = 0; bj < 2; ++bj) { const f32x4 v0 = acc[ai][bj][m][0], v1 = acc[ai][bj][m][1];
                    u32x4 w; w.x = cvt_pk_bf16(v0[0], v0[1]); w.y = cvt_pk_bf16(v0[2], v0[3]); w.z = cvt_pk_bf16(v1[0], v1[1]); w.w = cvt_pk_bf16(v1[2], v1[3]);
                    *(u32x4*)(rowp + bj * HALF) = w;
                    if ((row & 1023) >= 1022 && col0 + bj * HALF < acols) *(u32x4*)(side + ((size_t)(row >> 10) * 2 + (row & 1)) * acols + col0 + bj * HALF) = w; } }
    }
};

struct DiagOrder {
    int vb, nvb;
    __device__ bool next(int i, Unit& u) const { const int t = vb + i * nvb; if (t >= 128) return false; u.pm = t; u.pn = t >> 1; return true; }
    __device__ __forceinline__ void a_ready(const Unit&) const {}
    __device__ __forceinline__ void done(const Unit&) const {}
};
struct EpiS {
    static constexpr bool PERM = true, AFTER_DRAIN = false;
    float* S;
    __device__ __forceinline__ void operator()(const f32x4 (&acc)[2][2][4][2], const Unit& u, int wr, int wc, int fr, int fq) const {
        const int row0 = u.pm * BM + wr * 64 + fr, col0 = wc * 32 + 8 * fq;
#pragma unroll
        for (int ai = 0; ai < 2; ++ai)
#pragma unroll
            for (int m = 0; m < 4; ++m) { float* rowp = S + (size_t)(row0 + ai * HALF + m * 16) * 128 + col0; *(f32x4*)rowp = acc[ai][0][m][0]; *(f32x4*)(rowp + 4) = acc[ai][0][m][1]; }
    }
};
struct EpiY {
    static constexpr bool PERM = true, AFTER_DRAIN = false;
    const bf16_t* UX; const float* dsk; bf16_t* YG;
    __device__ __forceinline__ void operator()(const f32x4 (&acc)[2][2][4][2], const Unit& u, int wr, int wc, int fr, int fq) const {
        const int g = u.pn, row0 = u.pm * BM + wr * 64 + fr;
#pragma unroll
        for (int bj = 0; bj < 2; ++bj) {
            const int col = bj * HALF + wc * 32 + 8 * fq, t = col >> 4, c0 = col & 15;
            const f32x4 d0 = *(const f32x4*)(dsk + g * 16 + c0), d1 = *(const f32x4*)(dsk + g * 16 + c0 + 4);
            u32x4 uwv[2][4];
#pragma unroll
            for (int ai = 0; ai < 2; ++ai)
#pragma unroll
                for (int m = 0; m < 4; ++m) uwv[ai][m] = *(const u32x4*)(UX + (size_t)(row0 + ai * HALF + m * 16) * 384 + col);
#pragma unroll
            for (int ai = 0; ai < 2; ++ai)
#pragma unroll
                for (int m = 0; m < 4; ++m) {
                    const int row = row0 + ai * HALF + m * 16, seq = row - g * 512;
                    const u32x4 uw = uwv[ai][m];
                    const f32x4 a0 = acc[ai][bj][m][0], a1 = acc[ai][bj][m][1];
                    float y[8];
                    y[0] = a0[0] + d0[0] * __builtin_bit_cast(float, uw.x << 16); y[1] = a0[1] + d0[1] * __builtin_bit_cast(float, uw.x & 0xffff0000u);
                    y[2] = a0[2] + d0[2] * __builtin_bit_cast(float, uw.y << 16); y[3] = a0[3] + d0[3] * __builtin_bit_cast(float, uw.y & 0xffff0000u);
                    y[4] = a1[0] + d1[0] * __builtin_bit_cast(float, uw.z << 16); y[5] = a1[1] + d1[1] * __builtin_bit_cast(float, uw.z & 0xffff0000u);
                    y[6] = a1[2] + d1[2] * __builtin_bit_cast(float, uw.w << 16); y[7] = a1[3] + d1[3] * __builtin_bit_cast(float, uw.w & 0xffff0000u);
#pragma unroll
                    for (int e = 0; e < 8; ++e) { const float x = y[e], q = 0.7978845608028654f * (x + 0.044715f * x * x * x); y[e] = x * __builtin_amdgcn_rcpf(1.0f + __builtin_amdgcn_exp2f(-2.885390081777927f * q)); }
                    u32x4 w; w.x = cvt_pk_bf16(y[0], y[1]); w.y = cvt_pk_bf16(y[2], y[3]); w.z = cvt_pk_bf16(y[4], y[5]); w.w = cvt_pk_bf16(y[6], y[7]);
                    { bf16_t* yp = YG + ((size_t)seq * 16 + t) * 1024 + g * 16 + c0; asm volatile("global_store_dwordx4 %0, %1, off sc1\n\ts_nop 1" :: "v"(yp), "v"(w) : "memory"); }
                }
            asm volatile("" ::: "memory");
        }
    }
};

struct EpiRes {
    static constexpr bool PERM = true, AFTER_DRAIN = false;
    const float* base; const float* gate; float* O; int ldc;
    __device__ __forceinline__ void operator()(const f32x4 (&acc)[2][2][4][2], const Unit& u, int wr, int wc, int fr, int fq) const {
        const int row0 = u.pm * BM + wr * 64 + fr, col0 = u.pn * BM + wc * 32 + 8 * fq; const float* gp = gate + ((u.pm * BM) >> 12) * 12288 + col0;
        f32x4 gv[2][2];
#pragma unroll
        for (int bj = 0; bj < 2; ++bj) { gv[bj][0] = *(const f32x4*)(gp + bj * HALF); gv[bj][1] = *(const f32x4*)(gp + bj * HALF + 4); }
#pragma unroll
        for (int ai = 0; ai < 2; ++ai) {
            f32x4 xv[4][2][2];
#pragma unroll
            for (int m = 0; m < 4; ++m) { const size_t off = (size_t)(row0 + ai * HALF + m * 16) * ldc + col0;
#pragma unroll
                for (int bj = 0; bj < 2; ++bj) { xv[m][bj][0] = *(const f32x4*)(base + off + bj * HALF); xv[m][bj][1] = *(const f32x4*)(base + off + bj * HALF + 4); } }
#pragma unroll
            for (int m = 0; m < 4; ++m) { const size_t off = (size_t)(row0 + ai * HALF + m * 16) * ldc + col0;
#pragma unroll
                for (int bj = 0; bj < 2; ++bj) { *(f32x4*)(O + off + bj * HALF) = xv[m][bj][0] + gv[bj][0] * acc[ai][bj][m][0]; *(f32x4*)(O + off + bj * HALF + 4) = xv[m][bj][1] + gv[bj][1] * acc[ai][bj][m][1]; } }
            asm volatile("" ::: "memory");
        }
    }
};
struct EpiGlu {
    static constexpr bool PERM = true, AFTER_DRAIN = false;
    const bf16_t* Y; int ldy; const float* bias; bf16_t* O; int ldo;
    __device__ __forceinline__ void operator()(const f32x4 (&acc)[2][2][4][2], const Unit& u, int wr, int wc, int fr, int fq) const {
        const int row0 = u.pm * BM + wr * 64 + fr, col0 = u.pn * BM + wc * 32 + 8 * fq;
        f32x4 bv[2][2];
#pragma unroll
        for (int bj = 0; bj < 2; ++bj) { bv[bj][0] = *(const f32x4*)(bias + col0 + bj * HALF); bv[bj][1] = *(const f32x4*)(bias + col0 + bj * HALF + 4); }
#pragma unroll
        for (int ai = 0; ai < 2; ++ai) {
            u32x4 ywv[4][2];
#pragma unroll
            for (int m = 0; m < 4; ++m)
#pragma unroll
                for (int bj = 0; bj < 2; ++bj) ywv[m][bj] = *(const u32x4*)(Y + (size_t)(row0 + ai * HALF + m * 16) * ldy + col0 + bj * HALF);
#pragma unroll
            for (int m = 0; m < 4; ++m) { const int row = row0 + ai * HALF + m * 16;
#pragma unroll
                for (int bj = 0; bj < 2; ++bj) { const int col = col0 + bj * HALF; const u32x4 yw = ywv[m][bj];
                    const f32x4 z0 = acc[ai][bj][m][0] + bv[bj][0], z1 = acc[ai][bj][m][1] + bv[bj][1]; float o[8];
                    o[0] = __builtin_bit_cast(float, yw.x << 16) * __builtin_amdgcn_rcpf(1.f + __builtin_amdgcn_exp2f(-1.4426950408889634f * z0[0])); o[1] = __builtin_bit_cast(float, yw.x & 0xffff0000u) * __builtin_amdgcn_rcpf(1.f + __builtin_amdgcn_exp2f(-1.4426950408889634f * z0[1]));
                    o[2] = __builtin_bit_cast(float, yw.y << 16) * __builtin_amdgcn_rcpf(1.f + __builtin_amdgcn_exp2f(-1.4426950408889634f * z0[2])); o[3] = __builtin_bit_cast(float, yw.y & 0xffff0000u) * __builtin_amdgcn_rcpf(1.f + __builtin_amdgcn_exp2f(-1.4426950408889634f * z0[3]));
                    o[4] = __builtin_bit_cast(float, yw.z << 16) * __builtin_amdgcn_rcpf(1.f + __builtin_amdgcn_exp2f(-1.4426950408889634f * z1[0])); o[5] = __builtin_bit_cast(float, yw.z & 0xffff0000u) * __builtin_amdgcn_rcpf(1.f + __builtin_amdgcn_exp2f(-1.4426950408889634f * z1[1]));
                    o[6] = __builtin_bit_cast(float, yw.w << 16) * __builtin_amdgcn_rcpf(1.f + __builtin_amdgcn_exp2f(-1.4426950408889634f * z1[2])); o[7] = __builtin_bit_cast(float, yw.w & 0xffff0000u) * __builtin_amdgcn_rcpf(1.f + __builtin_amdgcn_exp2f(-1.4426950408889634f * z1[3]));
                    u32x4 w; w.x = cvt_pk_bf16(o[0], o[1]); w.y = cvt_pk_bf16(o[2], o[3]); w.z = cvt_pk_bf16(o[4], o[5]); w.w = cvt_pk_bf16(o[6], o[7]);
                    *(u32x4*)(O + (size_t)row * ldo + col) = w; } }
            asm volatile("" ::: "memory"); }
    }
};

struct EpiQKU {
    static constexpr bool PERM = true, AFTER_DRAIN = false;
    bf16_t* QB; bf16_t* KB; bf16_t* UX; const float* qg; const float* kg; float qscale, eps;
    __device__ __forceinline__ void operator()(const f32x4 (&acc)[2][2][4][2], const Unit& u, int wr, int wc, int fr, int fq) const {
        const int row0 = u.pm * BM + wr * 64 + fr, kind = u.pn >> 2, lc0 = (u.pn & 3) * BM + 64 * wc + 8 * fq;
        if (kind < 2) {
            const float* gp = kind == 0 ? qg : kg; const float gs = kind == 0 ? qscale : 1.0f; bf16_t* O = kind == 0 ? QB : KB;
            f32x4 gv[2][2];
#pragma unroll
            for (int bj = 0; bj < 2; ++bj) { gv[bj][0] = *(const f32x4*)(gp + 32 * bj + 8 * fq) * gs; gv[bj][1] = *(const f32x4*)(gp + 32 * bj + 8 * fq + 4) * gs; }
#pragma unroll
            for (int ai = 0; ai < 2; ++ai)
#pragma unroll
                for (int m = 0; m < 4; ++m) {
                    float ss = 0.f;
#pragma unroll
                    for (int bj = 0; bj < 2; ++bj)
#pragma unroll
                        for (int n = 0; n < 2; ++n) { const f32x4 x = acc[ai][bj][m][n]; ss += (x[0] * x[0] + x[1] * x[1]) + (x[2] * x[2] + x[3] * x[3]); }
                    ss += __shfl_xor(ss, 16); ss += __shfl_xor(ss, 32);
                    const float rs = rsqrtf(ss * (1.0f / 64.0f) + eps);
                    bf16_t* rowp = O + (size_t)(row0 + ai * HALF + m * 16) * 1024 + lc0;
#pragma unroll
                    for (int bj = 0; bj < 2; ++bj) { const f32x4 v0 = acc[ai][bj][m][0] * rs * gv[bj][0], v1 = acc[ai][bj][m][1] * rs * gv[bj][1];
                        u32x4 w; w.x = cvt_pk_bf16(v0[0], v0[1]); w.y = cvt_pk_bf16(v0[2], v0[3]); w.z = cvt_pk_bf16(v1[0], v1[1]); w.w = cvt_pk_bf16(v1[2], v1[3]);
                        { bf16_t* qp_ = rowp + 32 * bj; asm volatile("global_store_dwordx4 %0, %1, off sc1\n\ts_nop 1" :: "v"(qp_), "v"(w) : "memory"); } }
                }
        } else {
#pragma unroll
            for (int ai = 0; ai < 2; ++ai)
#pragma unroll
                for (int m = 0; m < 4; ++m) { const int row = row0 + ai * HALF + m * 16;
#pragma unroll
                    for (int bj = 0; bj < 2; ++bj) { const int lu = lc0 + 32 * bj, g = lu >> 4, c0 = lu & 15; const f32x4 v0 = acc[ai][bj][m][0], v1 = acc[ai][bj][m][1];
                        u32x4 w; w.x = cvt_pk_bf16(v0[0], v0[1]); w.y = cvt_pk_bf16(v0[2], v0[3]); w.z = cvt_pk_bf16(v1[0], v1[1]); w.w = cvt_pk_bf16(v1[2], v1[3]);
                        { bf16_t* up_ = UX + ((size_t)g * 512 + (row >> 4)) * 384 + (row & 15) * 16 + c0; asm volatile("global_store_dwordx4 %0, %1, off sc1\n\ts_nop 1" :: "v"(up_), "v"(w) : "memory"); } } }
        }
    }
};

__device__ __forceinline__ float dpp_ror1(float v) { return __builtin_bit_cast(float, __builtin_amdgcn_update_dpp(0, __builtin_bit_cast(int, v), 0x121, 0xf, 0xf, false)); }
__device__ __forceinline__ float dpp_ror2(float v) { return __builtin_bit_cast(float, __builtin_amdgcn_update_dpp(0, __builtin_bit_cast(int, v), 0x122, 0xf, 0xf, false)); }
struct EpiUpAct {
    static constexpr bool PERM = true, AFTER_DRAIN = false;
    bf16_t* ACT; bf16_t* sideA; bf16_t* sideB; const float* cw; const float* cbias; int nf;
    __device__ __forceinline__ void operator()(const f32x4 (&acc)[2][2][4][2], const Unit& u, int wr, int wc, int fr, int fq) const {
        const int f0 = u.pn * HALF + wc * 32 + 8 * fq;
        float w0[8], w1[8], w2[8], cb[8];
#pragma unroll
        for (int h = 0; h < 2; ++h) { const f32x4 a = *(const f32x4*)(cw + f0 + 4 * h), b = *(const f32x4*)(cw + nf + f0 + 4 * h), c = *(const f32x4*)(cw + 2 * nf + f0 + 4 * h), d = *(const f32x4*)(cbias + f0 + 4 * h);
#pragma unroll
            for (int e = 0; e < 4; ++e) { w0[4 * h + e] = a[e]; w1[4 * h + e] = b[e]; w2[4 * h + e] = c[e]; cb[4 * h + e] = d[e]; } }
#pragma unroll
        for (int ai = 0; ai < 2; ++ai) {
            const int rowb = u.pm * BM + ai * HALF + wr * 64, blk = rowb >> 6;
#pragma unroll
            for (int m = 0; m < 4; ++m) {
                const int row = rowb + m * 16 + fr;
                float o[8];
#pragma unroll
                for (int e = 0; e < 8; ++e) {
                    const float cur = acc[ai][0][m][e >> 2][e & 3], prv = (m > 0) ? acc[ai][0][m > 0 ? m - 1 : 0][e >> 2][e & 3] : 0.f, gg = acc[ai][1][m][e >> 2][e & 3];
                    const float p1 = dpp_ror1(fr == 15 ? prv : cur), p2 = dpp_ror2(fr >= 14 ? prv : cur);
                    const float x = w0[e] * p2 + w1[e] * p1 + w2[e] * cur + cb[e];
                    const float q = 0.7978845608028654f * (x + 0.044715f * x * x * x);
                    o[e] = x * __builtin_amdgcn_rcpf(1.0f + __builtin_amdgcn_exp2f(-2.885390081777927f * q)) * gg;
                }
                if (m > 0 || fr >= 2) { u32x4 w; w.x = cvt_pk_bf16(o[0], o[1]); w.y = cvt_pk_bf16(o[2], o[3]); w.z = cvt_pk_bf16(o[4], o[5]); w.w = cvt_pk_bf16(o[6], o[7]);
                    *(u32x4*)(ACT + (size_t)row * nf + f0) = w; }
                else { const f32x4 a0 = acc[ai][0][0][0], a1 = acc[ai][0][0][1], g0 = acc[ai][1][0][0], g1 = acc[ai][1][0][1];
                    u32x4 wa, wg; wa.x = cvt_pk_bf16(a0[0], a0[1]); wa.y = cvt_pk_bf16(a0[2], a0[3]); wa.z = cvt_pk_bf16(a1[0], a1[1]); wa.w = cvt_pk_bf16(a1[2], a1[3]);
                    wg.x = cvt_pk_bf16(g0[0], g0[1]); wg.y = cvt_pk_bf16(g0[2], g0[3]); wg.z = cvt_pk_bf16(g1[0], g1[1]); wg.w = cvt_pk_bf16(g1[2], g1[3]);
                    bf16_t* sb = sideB + ((size_t)(blk * 2 + fr) * 2) * nf + f0; *(u32x4*)sb = wa; *(u32x4*)(sb + nf) = wg; }
                if (m == 3 && fr >= 14) { const f32x4 a0 = acc[ai][0][3][0], a1 = acc[ai][0][3][1];
                    u32x4 wa; wa.x = cvt_pk_bf16(a0[0], a0[1]); wa.y = cvt_pk_bf16(a0[2], a0[3]); wa.z = cvt_pk_bf16(a1[0], a1[1]); wa.w = cvt_pk_bf16(a1[2], a1[3]);
                    *(u32x4*)(sideA + (size_t)(blk * 2 + (fr - 14)) * nf + f0) = wa; }
            }
        }
    }
};

struct OneUnit {
    int pm, pn;
    __device__ bool next(int i, Unit& u) const { if (i) return false; u.pm = pm; u.pn = pn; return true; }
    __device__ __forceinline__ void a_ready(const Unit&) const {}
    __device__ __forceinline__ void done(const Unit&) const {}
};

struct EpiResOutB {
    static constexpr bool PERM = true, AFTER_DRAIN = false;
    const float* base; const float* gate; bf16_t* O; int ldc;
    __device__ __forceinline__ void operator()(const f32x4 (&acc)[2][2][4][2], const Unit& u, int wr, int wc, int fr, int fq) const {
        const int row0 = u.pm * BM + wr * 64 + fr, col0 = u.pn * BM + wc * 32 + 8 * fq; const float* gp = gate + ((u.pm * BM) >> 12) * 12288 + col0;
        f32x4 gv[2][2];
#pragma unroll
        for (int bj = 0; bj < 2; ++bj) { gv[bj][0] = *(const f32x4*)(gp + bj * HALF); gv[bj][1] = *(const f32x4*)(gp + bj * HALF + 4); }
#pragma unroll
        for (int ai = 0; ai < 2; ++ai) {
            f32x4 xv[4][2][2];
#pragma unroll
            for (int m = 0; m < 4; ++m) { const size_t off = (size_t)(row0 + ai * HALF + m * 16) * ldc + col0;
#pragma unroll
                for (int bj = 0; bj < 2; ++bj) { xv[m][bj][0] = __builtin_nontemporal_load((const f32x4*)(base + off + bj * HALF)); xv[m][bj][1] = __builtin_nontemporal_load((const f32x4*)(base + off + bj * HALF + 4)); } }
#pragma unroll
            for (int m = 0; m < 4; ++m) { const size_t off = (size_t)(row0 + ai * HALF + m * 16) * ldc + col0;
#pragma unroll
                for (int bj = 0; bj < 2; ++bj) { const f32x4 v0 = xv[m][bj][0] + gv[bj][0] * acc[ai][bj][m][0], v1 = xv[m][bj][1] + gv[bj][1] * acc[ai][bj][m][1];
                    u32x4 w; w.x = cvt_pk_bf16(v0[0], v0[1]); w.y = cvt_pk_bf16(v0[2], v0[3]); w.z = cvt_pk_bf16(v1[0], v1[1]); w.w = cvt_pk_bf16(v1[2], v1[3]);
                    *(u32x4*)(O + off + bj * HALF) = w; } }
            asm volatile("" ::: "memory");
        }
    }
};
struct EpiResInB {
    static constexpr bool PERM = true, AFTER_DRAIN = false;
    const bf16_t* base; const float* gate; float* O; int ldc;
    __device__ __forceinline__ void operator()(const f32x4 (&acc)[2][2][4][2], const Unit& u, int wr, int wc, int fr, int fq) const {
        const int row0 = u.pm * BM + wr * 64 + fr, col0 = u.pn * BM + wc * 32 + 8 * fq; const float* gp = gate + ((u.pm * BM) >> 12) * 12288 + col0;
        f32x4 gv[2][2];
#pragma unroll
        for (int bj = 0; bj < 2; ++bj) { gv[bj][0] = *(const f32x4*)(gp + bj * HALF); gv[bj][1] = *(const f32x4*)(gp + bj * HALF + 4); }
#pragma unroll
        for (int ai = 0; ai < 2; ++ai) {
            u32x4 xw[4][2];
#pragma unroll
            for (int m = 0; m < 4; ++m)
#pragma unroll
                for (int bj = 0; bj < 2; ++bj) xw[m][bj] = *(const u32x4*)(base + (size_t)(row0 + ai * HALF + m * 16) * ldc + col0 + bj * HALF);
#pragma unroll
            for (int m = 0; m < 4; ++m) { const size_t off = (size_t)(row0 + ai * HALF + m * 16) * ldc + col0;
#pragma unroll
                for (int bj = 0; bj < 2; ++bj) { const u32x4 q = xw[m][bj];
                    const f32x4 x0 = {__builtin_bit_cast(float, q.x << 16), __builtin_bit_cast(float, q.x & 0xffff0000u), __builtin_bit_cast(float, q.y << 16), __builtin_bit_cast(float, q.y & 0xffff0000u)};
                    const f32x4 x1 = {__builtin_bit_cast(float, q.z << 16), __builtin_bit_cast(float, q.z & 0xffff0000u), __builtin_bit_cast(float, q.w << 16), __builtin_bit_cast(float, q.w & 0xffff0000u)};
                    __builtin_nontemporal_store(x0 + gv[bj][0] * acc[ai][bj][m][0], (f32x4*)(O + off + bj * HALF)); __builtin_nontemporal_store(x1 + gv[bj][1] * acc[ai][bj][m][1], (f32x4*)(O + off + bj * HALF + 4)); } }
            asm volatile("" ::: "memory");
        }
    }
};
}

#define LAS __attribute__((address_space(3)))
typedef unsigned short bf16_t;
typedef float f32x4 __attribute__((ext_vector_type(4)));
typedef unsigned u32x4 __attribute__((ext_vector_type(4)));
typedef unsigned u32x2 __attribute__((ext_vector_type(2)));

constexpr int BATCH = 2, SEQ = 4096, DM = 2048, NTOK = BATCH * SEQ;
constexpr int NH = 8, HD = 64, VD = 128, NG = 64, DFF = 5632, NQKU = 3072;
constexpr float EPS = 1e-6f, LOG2E = 1.4426950408889634f, C2 = 0.125f * LOG2E;
constexpr int LDS_BYTES = 147456;
constexpr int NTHREADS = 512, NWAVES = 8;

constexpr size_t MiB = (size_t)1 << 20;
constexpr size_t WS_CTL = 0, WS_MOD = 1 * MiB, WS_ZERO_BYTES = 2 * MiB;
constexpr size_t WS_WUP = 2 * MiB, WS_WDN = 46 * MiB, WS_X1 = 68 * MiB, WS_HB = 132 * MiB, WS_APRE = 164 * MiB;
constexpr size_t WS_WIN = 164 * MiB, WS_WGLU = 180 * MiB, WS_WOUT = 358 * MiB  , WS_QB = 190 * MiB, WS_KB = 206 * MiB, WS_VT = 222 * MiB;
constexpr size_t WS_UX = 238 * MiB, WS_MIX = 262 * MiB, WS_YG = 294 * MiB, WS_SBUF = 310 * MiB, WS_AMAT = 326 * MiB, WS_WMAT = 340 * MiB, WS_SIDEA = 348 * MiB, WS_SIDEB = 352 * MiB, WS_END = 366 * MiB;
constexpr size_t WS_SIDE = 64 * 1024;

#define GRID_SYNC_CG() do { asm volatile("s_waitcnt vmcnt(0) lgkmcnt(0)" ::: "memory"); grid.sync(); \
    if (__builtin_amdgcn_readfirstlane((int)(threadIdx.x >> 6)) == 0) { __builtin_amdgcn_fence(__ATOMIC_ACQUIRE, "agent"); asm volatile("s_waitcnt vmcnt(0)" ::: "memory"); } __syncthreads(); } while (0)
#define GRID_SYNC() do { xcd_barrier(xbar); } while (0)
#define XCD_SYNC() do { asm volatile("s_waitcnt vmcnt(0) lgkmcnt(0)" ::: "memory"); __syncthreads(); \
    if (threadIdx.x == 0) { const unsigned old_ = __hip_atomic_fetch_add(ctl + 64 * (20 + vx), 1u, __ATOMIC_RELAXED, __HIP_MEMORY_SCOPE_AGENT), gen_ = old_ / (unsigned)nb; \
        if (old_ + 1u == (gen_ + 1u) * (unsigned)nb) __hip_atomic_fetch_add(ctl + 64 * (28 + vx), 1u, __ATOMIC_RELAXED, __HIP_MEMORY_SCOPE_AGENT); \
        else while (__hip_atomic_load(ctl + 64 * (28 + vx), __ATOMIC_RELAXED, __HIP_MEMORY_SCOPE_AGENT) == gen_) __builtin_amdgcn_s_sleep(1); \
        __builtin_amdgcn_fence(__ATOMIC_ACQUIRE, "agent"); asm volatile("s_waitcnt vmcnt(0)" ::: "memory"); } \
    __syncthreads(); } while (0)

#define XB_TMO      128
#define XB_XCNT(j)  (256  + 64 * (j))
#define XB_XSUB(j)  (1280 + 64 * (j))
#define XB_XGEN(j)  (2304 + 64 * (j))
#define XB_TOP      3328
#define XB_TOPGEN   3392
#define XCD_BAR_WORDS 3456
#define XB_SPIN_CAP (1u << 18)

__device__ __forceinline__ unsigned xb_ld(unsigned* p)              { return __hip_atomic_load(p, __ATOMIC_RELAXED, __HIP_MEMORY_SCOPE_AGENT); }
__device__ __forceinline__ unsigned xb_add(unsigned* p, unsigned v) { return __hip_atomic_fetch_add(p, v, __ATOMIC_RELAXED, __HIP_MEMORY_SCOPE_AGENT); }
__device__ __forceinline__ unsigned xb_xcc_id() { return (unsigned)__builtin_amdgcn_s_getreg((3 << 11) | 20) & 0xFu; }
#define XB_SPIN(cond, bar) do { unsigned _sp = 0; while (cond) { __builtin_amdgcn_s_sleep(1); \
    if ((++_sp & 255u) == 0u) { if (xb_ld(&(bar)[XB_TMO])) break; if (_sp > XB_SPIN_CAP) { atomicAdd(&(bar)[XB_TMO], 1u); break; } } } } while (0)

struct XcdBarrier {
    unsigned* bar; unsigned x;
    volatile LAS unsigned* st;
};

__device__ __forceinline__ XcdBarrier xcd_barrier_post(unsigned* bar, volatile LAS unsigned* st) {
    XcdBarrier b; b.bar = bar; b.x = xb_xcc_id(); b.st = st;
    if (threadIdx.x == 0) (void)xb_add(&bar[XB_XCNT(b.x)], 1u);
    return b;
}
__device__ __forceinline__ void xcd_barrier_complete(unsigned* bar, unsigned x, unsigned& nloc, unsigned& nx) {
    const unsigned G = gridDim.x * gridDim.y * gridDim.z;
    unsigned sum, cnt, mine, sp = 0u;
    for (;;) {
        sum = 0u; cnt = 0u; mine = 0u;
#pragma unroll
        for (unsigned j = 0; j < 16; ++j) { const unsigned c = xb_ld(&bar[XB_XCNT(j)]); sum += c; cnt += (c > 0u) ? 1u : 0u; mine = (j == x) ? c : mine; }
        if (sum == G) break;
        __builtin_amdgcn_s_sleep(1);
        if ((++sp & 255u) == 0u) { if (xb_ld(&bar[XB_TMO])) break; if (sp > XB_SPIN_CAP) { atomicAdd(&bar[XB_TMO], 1u); break; } }
    }
    nloc = mine > 0u ? mine : 1u; nx = cnt > 0u ? cnt : 1u;
}

__device__ __forceinline__ void xcd_barrier(const XcdBarrier& b) {
    asm volatile("s_waitcnt vmcnt(0)" ::: "memory");
    __syncthreads();
    if (threadIdx.x == 0) {
        unsigned* bar = b.bar;
        __builtin_amdgcn_s_waitcnt(0);
        unsigned nloc = b.st[0], nx = b.st[1];
        if (nloc == 0u) { xcd_barrier_complete(bar, b.x, nloc, nx); b.st[0] = nloc; b.st[1] = nx; }
        const unsigned old = xb_add(&bar[XB_XSUB(b.x)], 1u);
        const unsigned gen = old / nloc;
        if (old + 1u == (gen + 1u) * nloc) {
            __builtin_amdgcn_fence(__ATOMIC_RELEASE, "agent");
            asm volatile("s_waitcnt vmcnt(0)" ::: "memory");
            const unsigned og = xb_add(&bar[XB_TOP], 1u);
            const unsigned tg = og / nx;
            if (og + 1u == (tg + 1u) * nx) xb_add(&bar[XB_TOPGEN], 1u);
            else XB_SPIN(xb_ld(&bar[XB_TOPGEN]) == tg, bar);
            __builtin_amdgcn_fence(__ATOMIC_ACQUIRE, "agent");
            xb_add(&bar[XB_XGEN(b.x)], 1u);
            asm volatile("s_waitcnt vmcnt(0)" ::: "memory");
        } else {
            XB_SPIN(xb_ld(&bar[XB_XGEN(b.x)]) == gen, bar);
            __builtin_amdgcn_fence(__ATOMIC_ACQUIRE, "agent");
            asm volatile("s_waitcnt vmcnt(0)" ::: "memory");
        }
    }
    __syncthreads();
}

struct Params { const float* in[29]; float* out; unsigned char* ws; };

enum { I_X = 0, I_C, I_WADA, I_BADA, I_N1G, I_N2G, I_WIN, I_QG, I_KG, I_LQ1, I_LK1, I_LQ2, I_LK2, I_SUBG, I_ARE, I_AIM, I_LOGDT, I_BRE, I_BIM, I_CRE, I_CIM, I_SD,
       I_WGLU, I_BGLU, I_WOUT, I_WUP, I_CONVW, I_CONVB, I_WDN };

__device__ __forceinline__ int opaque_tid() { int t = threadIdx.x; asm volatile("" : "+v"(t)); return t; }
__device__ __forceinline__ float wave_sum(float v) {
#pragma unroll
    for (int o = 1; o < 64; o <<= 1) v += __shfl_xor(v, o);
    return v;
}
__device__ __forceinline__ unsigned f2bf(float f) { unsigned u = __builtin_bit_cast(unsigned, f); return (u + 0x7fffu + ((u >> 16) & 1u)) >> 16; }
__device__ __forceinline__ unsigned pk2(float lo, float hi) { return f2bf(lo) | (f2bf(hi) << 16); }
__device__ __forceinline__ float bf2f(unsigned short h) { return __builtin_bit_cast(float, (unsigned)h << 16); }
__device__ __forceinline__ float bflo(unsigned w) { return __builtin_bit_cast(float, w << 16); }
__device__ __forceinline__ float bfhi(unsigned w) { return __builtin_bit_cast(float, w & 0xffff0000u); }
__device__ __forceinline__ float gelu_tanh(float x) {
    const float u = 0.7978845608028654f * (x + 0.044715f * x * x * x);
    return x * __builtin_amdgcn_rcpf(1.0f + __builtin_amdgcn_exp2f(-2.0f * LOG2E * u));
}
__device__ __forceinline__ float sigmoidf_(float z) { return 1.0f * __builtin_amdgcn_rcpf(1.0f + __builtin_amdgcn_exp2f(-LOG2E * z)); }

__device__ __forceinline__ void transpose_tile(const float* __restrict__ W, int N, bf16_t* __restrict__ WT, int ldt, int k0, int n0, int drow0, LAS float* tile, int tid, int drow1 = -1) {
#pragma unroll
    for (int ps = 0; ps < 2; ++ps) {
        const int kk = ps * 32 + (tid >> 4), nn = (tid & 15) * 4;
        const f32x4 v = *(const f32x4*)(W + (size_t)(k0 + kk) * N + n0 + nn);
        tile[kk * 65 + nn + 0] = v.x; tile[kk * 65 + nn + 1] = v.y; tile[kk * 65 + nn + 2] = v.z; tile[kk * 65 + nn + 3] = v.w;
    }
    __syncthreads();
    const int n = tid >> 3, kc = tid & 7;
    u32x4 o;
    o.x = pk2(tile[(8 * kc + 0) * 65 + n], tile[(8 * kc + 1) * 65 + n]);
    o.y = pk2(tile[(8 * kc + 2) * 65 + n], tile[(8 * kc + 3) * 65 + n]);
    o.z = pk2(tile[(8 * kc + 4) * 65 + n], tile[(8 * kc + 5) * 65 + n]);
    o.w = pk2(tile[(8 * kc + 6) * 65 + n], tile[(8 * kc + 7) * 65 + n]);
    const int drow = (drow1 >= 0 && n >= 32) ? drow1 + (n - 32) : drow0 + n;
    *(u32x4*)(WT + (size_t)drow * ldt + k0 + 8 * kc) = o;
    __syncthreads();
}


__device__ __forceinline__ void transpose_tile_w(const float* __restrict__ W, int N, bf16_t* __restrict__ WT, int ldt, int k0, int n0, int drow0, int drow1, LAS float* wt, int lane) {
    const int rr = lane >> 4, c4 = (lane & 15) * 4;
#pragma unroll
    for (int hf = 0; hf < 2; ++hf) {
        f32x4 v[8];
#pragma unroll
        for (int j = 0; j < 8; ++j) v[j] = __builtin_nontemporal_load((const f32x4*)(W + (size_t)(k0 + (hf * 8 + j) * 4 + rr) * N + n0 + c4));
#pragma unroll
        for (int j = 0; j < 8; ++j) { LAS float* p = wt + ((hf * 8 + j) * 4 + rr) * 65 + c4; p[0] = v[j].x; p[1] = v[j].y; p[2] = v[j].z; p[3] = v[j].w; }
    }
    asm volatile("s_waitcnt lgkmcnt(0)" ::: "memory");
#pragma unroll
    for (int o = 0; o < 8; ++o) {
        const int idx = o * 64 + lane, n = idx >> 3, kc = idx & 7; const LAS float* p = wt + (8 * kc) * 65 + n;
        u32x4 w; w.x = pk2(p[0], p[65]); w.y = pk2(p[2 * 65], p[3 * 65]); w.z = pk2(p[4 * 65], p[5 * 65]); w.w = pk2(p[6 * 65], p[7 * 65]);
        const int drow = (drow1 >= 0 && n >= 32) ? drow1 + (n - 32) : drow0 + n;
        *(u32x4*)(WT + (size_t)drow * ldt + k0 + 8 * kc) = w;
    }
    asm volatile("s_waitcnt lgkmcnt(0)" ::: "memory");
}
constexpr int CT_WIN = 32 * 64, CT_GLU = 16 * 16, CT_OUT = 32 * 32, CT_UP = 32 * 176, CT_DN = 88 * 32;
__device__ __forceinline__ void convert_tile_w(const Params& P, int which, int r, LAS float* wt, int lane) {
    unsigned char* ws = P.ws;
    if (which == 0) { const int kb = r / 64, n0 = (r % 64) * 64;
        if (n0 >= 2048 && n0 < 3072) { transpose_tile_w(P.in[I_WIN], 4096, (bf16_t*)(ws + WS_WIN), 2048, kb * 64, n0, 3072 + (n0 - 2048), -1, wt, lane); return; }
        const int lq = n0 < 2048 ? n0 : 2048 + (n0 - 3072), tb = lq & ~255, wcg = (lq & 255) >> 6;
        transpose_tile_w(P.in[I_WIN], 4096, (bf16_t*)(ws + WS_WIN), 2048, kb * 64, n0, tb + 32 * wcg, tb + 128 + 32 * wcg, wt, lane); return; }
    if (which == 1) { transpose_tile_w(P.in[I_WGLU], 1024, (bf16_t*)(ws + WS_WGLU), 1024, (r / 16) * 64, (r % 16) * 64, (r % 16) * 64, -1, wt, lane); return; }
    if (which == 2) { transpose_tile_w(P.in[I_WOUT], 2048, (bf16_t*)(ws + WS_WOUT), 2048, (r / 32) * 64, (r % 32) * 64, (r % 32) * 64, -1, wt, lane); return; }
    if (which == 3) { const int n0 = (r % 176) * 64, isg = n0 >= DFF, f0 = n0 - isg * DFF;
        transpose_tile_w(P.in[I_WUP], 11264, (bf16_t*)(ws + WS_WUP), 2048, (r / 176) * 64, n0, (f0 >> 7) * 256 + isg * 128 + (f0 & 127), -1, wt, lane); return; }
    transpose_tile_w(P.in[I_WDN], 2048, (bf16_t*)(ws + WS_WDN), 5632, (r / 32) * 64, (r % 32) * 64, (r % 32) * 64, -1, wt, lane);
}

__device__ __forceinline__ void gemv_job(const Params& P, int job, LAS float* red, int tid) {
    const int c4 = tid & 15, rsub = tid >> 4;
    const float* cvec = P.in[I_C];
    const f32x4* W4 = (const f32x4*)P.in[I_WADA] + job * 16 + c4;
    f32x4 a0 = {0.f, 0.f, 0.f, 0.f}, a1 = {0.f, 0.f, 0.f, 0.f};
#pragma unroll 8
    for (int i = 0; i < 64; ++i) {
        const int k = i * 32 + rsub;
        const f32x4 w = __builtin_nontemporal_load(W4 + (size_t)k * 3072);
        const float c0 = cvec[k], c1 = cvec[2048 + k];
        const float s0 = c0 * sigmoidf_(c0), s1 = c1 * sigmoidf_(c1);
        a0 += w * s0; a1 += w * s1;
    }
    LAS f32x4* red4 = (LAS f32x4*)red;
    red4[(rsub * 2 + 0) * 16 + c4] = a0; red4[(rsub * 2 + 1) * 16 + c4] = a1;
    __syncthreads();
    if (tid < 32) {
        const int b = tid >> 4, c = tid & 15;
        f32x4 s = {0.f, 0.f, 0.f, 0.f};
#pragma unroll 8
        for (int r = 0; r < 32; ++r) s += red4[(r * 2 + b) * 16 + c];
        const int col = (job * 16 + c) * 4;
        s += *(const f32x4*)(P.in[I_BADA] + col);
        *(f32x4*)((float*)(P.ws + WS_MOD) + b * 12288 + col) = s;
    }
    __syncthreads();
}

__device__ __forceinline__ void norm_mod_store(const f32x4 (&v)[8], const float* g, const float* shift, const float* scale, bf16_t* orow, int lane) {
    float ss = 0.f;
#pragma unroll
    for (int j = 0; j < 8; ++j) ss += (v[j].x * v[j].x + v[j].y * v[j].y) + (v[j].z * v[j].z + v[j].w * v[j].w);
    ss = wave_sum(ss);
    const float rs = rsqrtf(ss * (1.0f / 2048.0f) + EPS);
#pragma unroll
    for (int j = 0; j < 8; ++j) {
        const int col = 4 * (lane + 64 * j);
        const f32x4 g4 = *(const f32x4*)(g + col), sh = *(const f32x4*)(shift + col), sc = *(const f32x4*)(scale + col);
        const f32x4 h = (v[j] * rs * g4) * (sc + 1.0f) + sh;
        u32x2 o; o.x = pk2(h.x, h.y); o.y = pk2(h.z, h.w);
        *(u32x2*)(orow + col) = o;
    }
}

__device__ __forceinline__ void ssm_abar(const Params& P, int g, int p, float& abr, float& abi, float& cr, float& ci) {
    const float dt = expf(P.in[I_LOGDT][g]);
    const float ar = P.in[I_ARE][g * 64 + p], ai = P.in[I_AIM][g * 64 + p];
    const float mag = expf(dt * ar); abr = mag * cosf(dt * ai); abi = mag * sinf(dt * ai);
    const float den = ar * ar + ai * ai, nr = abr - 1.0f, ni = abi;
    cr = (nr * ar + ni * ai) / den; ci = (ni * ar - nr * ai) / den;
}
__device__ __forceinline__ void ssm_tables_job(const Params& P, int g, LAS float* L, int tid) {
    LAS float* pwr = L;
    LAS float* pwi = L + 17 * 64;
    LAS float* bbr = L + 34 * 64;
    LAS float* bbi = bbr + 1024;
    LAS float* ccr = bbi + 1024;
    LAS float* cci = ccr + 1024;
    LAS float* kk = cci + 1024;
    if (tid < 64) {
        const int p = tid; float abr, abi, cr, ci; ssm_abar(P, g, p, abr, abi, cr, ci);
        float xr = 1.f, xi = 0.f;
        for (int n = 0; n <= 16; ++n) { pwr[n * 64 + p] = xr; pwi[n * 64 + p] = xi; const float nr = xr * abr - xi * abi, ni = xr * abi + xi * abr; xr = nr; xi = ni; }
        for (int c = 0; c < 16; ++c) { const float br = P.in[I_BRE][(g * 64 + p) * 16 + c], bi = P.in[I_BIM][(g * 64 + p) * 16 + c]; bbr[p * 16 + c] = cr * br - ci * bi; bbi[p * 16 + c] = cr * bi + ci * br; }
    }
    for (int i = tid; i < 1024; i += NTHREADS) { ccr[i] = P.in[I_CRE][g * 1024 + i]; cci[i] = P.in[I_CIM][g * 1024 + i]; }
    __syncthreads();
    {
        const int pair = tid & 255, c = pair >> 4, c2 = pair & 15, th = tid >> 8;
        float acc[8];
#pragma unroll
        for (int j = 0; j < 8; ++j) acc[j] = 0.f;
        for (int p = 0; p < 64; ++p) {
            const float cr_ = ccr[c * 64 + p], ci_ = cci[c * 64 + p], br = bbr[p * 16 + c2], bi = bbi[p * 16 + c2];
            const float mr = cr_ * br - ci_ * bi, mi = cr_ * bi + ci_ * br;
#pragma unroll
            for (int j = 0; j < 8; ++j) { const int tau = th * 8 + j; acc[j] += mr * pwr[tau * 64 + p] - mi * pwi[tau * 64 + p]; }
        }
#pragma unroll
        for (int j = 0; j < 8; ++j) kk[(th * 8 + j) * 256 + c * 16 + c2] = acc[j];
    }
    __syncthreads();
    bf16_t* AM = (bf16_t*)(P.ws + WS_AMAT) + (size_t)g * 256 * 384;
    for (int ch = tid; ch < 256 * 48; ch += NTHREADS) {
        const int col = ch / 48, k0 = (ch % 48) * 8, t = col >> 4, c = col & 15; float v[8];
        if (k0 < 256) { const int sidx = k0 >> 4, c2 = k0 & 15;
#pragma unroll
            for (int e = 0; e < 8; ++e) v[e] = (sidx <= t) ? kk[(t - sidx) * 256 + c * 16 + c2 + e] : 0.f;
        } else if (k0 < 320) { const int p0 = k0 - 256;
#pragma unroll
            for (int e = 0; e < 8; ++e) v[e] = ccr[c * 64 + p0 + e] * pwr[(t + 1) * 64 + p0 + e] - cci[c * 64 + p0 + e] * pwi[(t + 1) * 64 + p0 + e];
        } else { const int p0 = k0 - 320;
#pragma unroll
            for (int e = 0; e < 8; ++e) v[e] = -(ccr[c * 64 + p0 + e] * pwi[(t + 1) * 64 + p0 + e] + cci[c * 64 + p0 + e] * pwr[(t + 1) * 64 + p0 + e]);
        }
        u32x4 o; o.x = pk2(v[0], v[1]); o.y = pk2(v[2], v[3]); o.z = pk2(v[4], v[5]); o.w = pk2(v[6], v[7]);
        *(u32x4*)(AM + (size_t)col * 384 + k0) = o;
    }
    bf16_t* WM = (bf16_t*)(P.ws + WS_WMAT) + (size_t)g * 256 * 256;
    for (int ch = tid; ch < 256 * 32; ch += NTHREADS) {
        const int row = ch >> 5, k0 = (ch & 31) * 8, sidx = k0 >> 4, c2 = k0 & 15; float v[8];
#pragma unroll
        for (int e = 0; e < 8; ++e) v[e] = 0.f;
        if (row < 128) { const int p = row & 63; const float wr_ = pwr[(15 - sidx) * 64 + p], wi_ = pwi[(15 - sidx) * 64 + p];
#pragma unroll
            for (int e = 0; e < 8; ++e) { const float br = bbr[p * 16 + c2 + e], bi = bbi[p * 16 + c2 + e]; v[e] = (row < 64) ? (wr_ * br - wi_ * bi) : (wr_ * bi + wi_ * br); } }
        u32x4 o; o.x = pk2(v[0], v[1]); o.y = pk2(v[2], v[3]); o.z = pk2(v[4], v[5]); o.w = pk2(v[6], v[7]);
        *(u32x4*)(WM + (size_t)row * 256 + k0) = o;
    }
    __syncthreads();
}
__device__ __forceinline__ void ssm_carry_job(const Params& P, int g, int b, LAS float* L, int tid) {
    const int p = tid & 63, seg = tid >> 6;
    float abr, abi, cr, ci; ssm_abar(P, g, p, abr, abi, cr, ci);
    float a16r = abr, a16i = abi;
#pragma unroll
    for (int i = 0; i < 4; ++i) { const float nr = a16r * a16r - a16i * a16i, ni = 2.f * a16r * a16i; a16r = nr; a16i = ni; }
    float a512r = a16r, a512i = a16i;
#pragma unroll
    for (int i = 0; i < 5; ++i) { const float nr = a512r * a512r - a512i * a512i, ni = 2.f * a512r * a512i; a512r = nr; a512i = ni; }
    const float* S = (const float*)(P.ws + WS_SBUF) + ((size_t)g * 512 + b * 256 + seg * 32) * 128 + p;
    float xr = 0.f, xi = 0.f;
#pragma unroll 8
    for (int jj = 0; jj < 32; ++jj) { const float sr = S[jj * 128], si = S[jj * 128 + 64]; const float nr = a16r * xr - a16i * xi + sr, ni = a16r * xi + a16i * xr + si; xr = nr; xi = ni; }
    L[seg * 128 + p] = xr; L[seg * 128 + 64 + p] = xi;
    __syncthreads();
    float c0r = 0.f, c0i = 0.f;
    for (int q = 0; q < seg; ++q) { const float er = L[q * 128 + p], ei = L[q * 128 + 64 + p]; const float nr = a512r * c0r - a512i * c0i + er, ni = a512r * c0i + a512i * c0r + ei; c0r = nr; c0i = ni; }
    bf16_t* X = (bf16_t*)(P.ws + WS_UX) + ((size_t)g * 512 + b * 256 + seg * 32) * 384 + 256 + p;
    xr = c0r; xi = c0i;
#pragma unroll 8
    for (int jj = 0; jj < 32; ++jj) {
        X[(size_t)jj * 384] = (bf16_t)f2bf(xr); X[(size_t)jj * 384 + 64] = (bf16_t)f2bf(xi);
        const float sr = S[jj * 128], si = S[jj * 128 + 64]; const float nr = a16r * xr - a16i * xi + sr, ni = a16r * xi + a16i * xr + si; xr = nr; xi = ni;
    }
    __syncthreads();
}

typedef float f32x16 __attribute__((ext_vector_type(16)));
typedef short bf16x8v __attribute__((ext_vector_type(8)));
typedef short s16x4v __attribute__((ext_vector_type(4)));
typedef float f32x2v __attribute__((ext_vector_type(2)));
typedef __bf16 bf16x2v __attribute__((ext_vector_type(2)));
__device__ __forceinline__ unsigned cvtpk(float lo, float hi) { f32x2v v = {lo, hi}; bf16x2v b = __builtin_convertvector(v, bf16x2v); return __builtin_bit_cast(unsigned, b); }
constexpr int AT_KP = 144, AT_VP = 144, AT_K1 = 0, AT_K2 = 64 * AT_KP, AT_V = 2 * 64 * AT_KP, AT_STAGE = AT_V + 128 * AT_VP;

__device__ __forceinline__ void attn_unit(const Params& P, LAS unsigned char* lds, int b, int h, int qb, float lam, float wnd2b, int tid) {
    const int lane = tid & 63, wave = __builtin_amdgcn_readfirstlane(tid >> 6), sm = wave >> 2, rb = wave & 3, l31 = lane & 31, kg = lane >> 5;
    const bf16_t* QB = (const bf16_t*)(P.ws + WS_QB); const bf16_t* KB = (const bf16_t*)(P.ws + WS_KB); const bf16_t* VT = (const bf16_t*)(P.ws + WS_VT);
    bf16_t* MIX = (bf16_t*)(P.ws + WS_MIX);
    const int q0 = qb * 128; const size_t tokb = (size_t)b * SEQ;
    const int qw0 = q0 + 32 * rb, qpos = qw0 + l31;
    bf16x8v qf[4];
    { const bf16_t* qp = QB + (tokb + qpos) * 1024 + h * 128 + sm * 64 + 8 * kg;
#pragma unroll
      for (int ks = 0; ks < 4; ++ks) qf[ks] = *(const bf16x8v*)(qp + 16 * ks); }
    const float sl2 = exp2f(-(float)(h + 1)) * LOG2E;
    float l = 0.f; const float bref = 0.5f * (wnd2b - 64.0f);
    f32x16 o[4];
#pragma unroll
    for (int vb = 0; vb < 4; ++vb)
#pragma unroll
        for (int r = 0; r < 16; ++r) o[vb][r] = 0.f;
    const int NT = 2 * (qb + 1);
    int t0 = (int)floorf(((float)(q0 - 63) - wnd2b / sl2) * (1.0f / 64.0f)) + 1; t0 = t0 < 0 ? 0 : t0;
    const int krow = tid >> 3, kch = tid & 7;
    const bf16_t* kg1 = KB + (tokb + krow) * 1024 + h * 128 + kch * 8;
    const bf16_t* vg0 = VT + (size_t)(h * 128 + krow) * NTOK + tokb + kch * 8;
    const bf16_t* vg1 = vg0 + (size_t)64 * NTOK;
    const int kofs = krow * AT_KP + kch * 16, vofs0 = AT_V + krow * AT_VP + ((kch >> 1) * 16 + (kch & 1) * 4) * 2, vofs1 = vofs0 + 64 * AT_VP;
    u32x4 rk1, rk2, rv0, rv1;
#define AT_LOAD(t) do { const bf16_t* kp_ = kg1 + (size_t)(t) * 64 * 1024; rk1 = *(const u32x4*)kp_; rk2 = *(const u32x4*)(kp_ + 64); rv0 = *(const u32x4*)(vg0 + (t) * 64); rv1 = *(const u32x4*)(vg1 + (t) * 64); } while (0)
#define AT_STORE(base) do { *(LAS u32x4*)((base) + AT_K1 + kofs) = rk1; *(LAS u32x4*)((base) + AT_K2 + kofs) = rk2; \
        *(LAS u32x2*)((base) + vofs0) = (u32x2){rv0.x, rv0.y}; *(LAS u32x2*)((base) + vofs0 + 16) = (u32x2){rv0.z, rv0.w}; \
        *(LAS u32x2*)((base) + vofs1) = (u32x2){rv1.x, rv1.y}; *(LAS u32x2*)((base) + vofs1 + 16) = (u32x2){rv1.z, rv1.w}; } while (0)
    AT_LOAD(t0); AT_STORE(lds + (t0 & 1) * AT_STAGE); __syncthreads();
    for (int t = t0; t < NT; ++t) {
        LAS unsigned char* cur = lds + (t & 1) * AT_STAGE; LAS unsigned char* nxt = lds + ((t + 1) & 1) * AT_STAGE;
        if (t + 1 < NT) AT_LOAD(t + 1);
        const int kv0 = t * 64;
        if (kv0 <= qw0 + 31) {
            f32x16 p0, p1;
            { const float cbase = sl2 * (float)(kv0 + 4 * kg - qpos) - bref, s32 = 32.f * sl2;
#pragma unroll
              for (int r = 0; r < 16; ++r) { p0[r] = cbase + sl2 * (float)((r & 3) + 8 * (r >> 2)); p1[r] = p0[r] + s32; } }
            const LAS unsigned char* kb = cur + (sm ? AT_K2 : AT_K1) + l31 * AT_KP + kg * 16;
            __builtin_amdgcn_s_setprio(1);
#pragma unroll
            for (int ks = 0; ks < 4; ++ks) {
                const bf16x8v a0 = *(const LAS bf16x8v*)(kb + ks * 32), a1 = *(const LAS bf16x8v*)(kb + 32 * AT_KP + ks * 32);
                p0 = __builtin_amdgcn_mfma_f32_32x32x16_bf16(a0, qf[ks], p0, 0, 0, 0);
                p1 = __builtin_amdgcn_mfma_f32_32x32x16_bf16(a1, qf[ks], p1, 0, 0, 0);
            }
            __builtin_amdgcn_s_setprio(0);
            if (kv0 + 63 > qw0) {
                const int kb0 = kv0 + 4 * kg;
#pragma unroll
                for (int r = 0; r < 16; ++r) { const int kvp = kb0 + (r & 3) + 8 * (r >> 2); if (kvp > qpos) p0[r] = -INFINITY; if (kvp + 32 > qpos) p1[r] = -INFINITY; }
            }
            float ps = 0.f;
#pragma unroll
            for (int r = 0; r < 16; ++r) { p0[r] = __builtin_amdgcn_exp2f(p0[r]); p1[r] = __builtin_amdgcn_exp2f(p1[r]); ps += p0[r] + p1[r]; }
            l += ps;
            bf16x8v pb[4];
            { u32x4 w;
              w.x = cvtpk(p0[0], p0[1]); w.y = cvtpk(p0[2], p0[3]); w.z = cvtpk(p0[4], p0[5]); w.w = cvtpk(p0[6], p0[7]); pb[0] = __builtin_bit_cast(bf16x8v, w);
              w.x = cvtpk(p0[8], p0[9]); w.y = cvtpk(p0[10], p0[11]); w.z = cvtpk(p0[12], p0[13]); w.w = cvtpk(p0[14], p0[15]); pb[1] = __builtin_bit_cast(bf16x8v, w);
              w.x = cvtpk(p1[0], p1[1]); w.y = cvtpk(p1[2], p1[3]); w.z = cvtpk(p1[4], p1[5]); w.w = cvtpk(p1[6], p1[7]); pb[2] = __builtin_bit_cast(bf16x8v, w);
              w.x = cvtpk(p1[8], p1[9]); w.y = cvtpk(p1[10], p1[11]); w.z = cvtpk(p1[12], p1[13]); w.w = cvtpk(p1[14], p1[15]); pb[3] = __builtin_bit_cast(bf16x8v, w); }
            const LAS unsigned char* vbp = cur + AT_V + l31 * AT_VP + kg * 16;
            __builtin_amdgcn_s_setprio(1);
#pragma unroll
            for (int vb = 0; vb < 4; ++vb)
#pragma unroll
                for (int k2 = 0; k2 < 4; ++k2) {
                    const bf16x8v av = *(const LAS bf16x8v*)(vbp + vb * 32 * AT_VP + k2 * 32);
                    o[vb] = __builtin_amdgcn_mfma_f32_32x32x16_bf16(av, pb[k2], o[vb], 0, 0, 0);
                }
            __builtin_amdgcn_s_setprio(0);
        }
        if (t + 1 < NT) AT_STORE(nxt);
        __syncthreads();
    }
#undef AT_LOAD
#undef AT_STORE
    const float inv = 1.0f / (l + __shfl_xor(l, 32));
    LAS float* ob = (LAS float*)lds;
    if (sm == 1) {
#pragma unroll
        for (int vb = 0; vb < 4; ++vb)
#pragma unroll
            for (int r = 0; r < 16; ++r) ob[((rb * 4 + vb) * 16 + r) * 64 + lane] = o[vb][r] * inv;
    }
    __syncthreads();
    if (sm == 0) {
        float ss = 0.f;
#pragma unroll
        for (int vb = 0; vb < 4; ++vb)
#pragma unroll
            for (int r = 0; r < 16; ++r) { const float d = o[vb][r] * inv - lam * ob[((rb * 4 + vb) * 16 + r) * 64 + lane]; o[vb][r] = d; ss += d * d; }
        ss += __shfl_xor(ss, 32);
        const float rn = rsqrtf(ss * (1.0f / 128.0f) + EPS) * 0.8f;
        const float* gs = P.in[I_SUBG];
        bf16_t* mp = MIX + (tokb + qpos) * 2048 + h * 128;
#pragma unroll
        for (int vb = 0; vb < 4; ++vb)
#pragma unroll
            for (int r4 = 0; r4 < 4; ++r4) {
                const int vc = 32 * vb + 8 * r4 + 4 * kg; const f32x4 g4 = *(const f32x4*)(gs + vc);
                u32x2 w; w.x = cvtpk(o[vb][4 * r4 + 0] * rn * g4.x, o[vb][4 * r4 + 1] * rn * g4.y); w.y = cvtpk(o[vb][4 * r4 + 2] * rn * g4.z, o[vb][4 * r4 + 3] * rn * g4.w);
                *(u32x2*)(mp + vc) = w;
            }
    }
    __syncthreads();
}

constexpr int LATE_SPLIT = 288;
#define LATE_W_ITEM(done_, cw_, lo_, hi_) do { \
        constexpr int J_OUT_ = 32 * 32, J_UP_ = 32 * 176, J_LATE_ = J_OUT_ + J_UP_;     \
        const int tid_ = opaque_tid(); \
        if (tid_ == 0) lctl[3] = __hip_atomic_fetch_add(ctl + 64 * (cw_), 1u, __ATOMIC_RELAXED, __HIP_MEMORY_SCOPE_AGENT); \
        __syncthreads(); \
        const int it_ = (lo_) + __builtin_amdgcn_readfirstlane((int)lctl[3]); \
        __syncthreads(); \
        if (it_ >= (hi_) || it_ * 16 >= J_LATE_) { done_ = true; break; } \
        { const int w_ = __builtin_amdgcn_readfirstlane(tid_ >> 6), ln_ = tid_ & 63; \
          for (int q_ = 0; q_ < 2; ++q_) { const int r_ = it_ * 16 + q_ * 8 + w_; if (r_ < J_LATE_) { if (r_ < J_OUT_) convert_tile_w(P, 2, r_, ldsf + w_ * (64 * 65), ln_); else convert_tile_w(P, 3, r_ - J_OUT_, ldsf + w_ * (64 * 65), ln_); } } } \
        __syncthreads(); } while (0)

#define WDN_QUEUE() do { for (;;) { const int tid_ = opaque_tid(); \
        if (tid_ == 0) lctl[3] = __hip_atomic_fetch_add(ctl + 64 * 13, 1u, __ATOMIC_RELAXED, __HIP_MEMORY_SCOPE_AGENT); \
        __syncthreads(); \
        const int it_ = __builtin_amdgcn_readfirstlane((int)lctl[3]); \
        __syncthreads(); \
        if (it_ * 8 >= 88 * 32) break; \
        { const int w_ = __builtin_amdgcn_readfirstlane(tid_ >> 6); convert_tile_w(P, 4, it_ * 8 + w_, ldsf + w_ * (64 * 65), tid_ & 63); } __syncthreads(); } } while (0)

__global__ void __launch_bounds__(NTHREADS, 2) fwd_kernel(Params P) {
    extern __shared__ __attribute__((aligned(16))) unsigned char lds_raw[];
    cg::grid_group grid = cg::this_grid();
    LAS unsigned char* lds = (LAS unsigned char*)lds_raw;
    LAS float* ldsf = (LAS float*)lds_raw;
    const int tid = threadIdx.x, lane = tid & 63, wave = __builtin_amdgcn_readfirstlane(tid >> 6);
    const int G = gridDim.x, bid = blockIdx.x;
    unsigned* ctl = (unsigned*)(P.ws + WS_CTL);
    LAS unsigned* lctl = (LAS unsigned*)(lds_raw + LDS_BYTES - 256);
    if (tid == 0) { lctl[4] = 0u; lctl[5] = 0u; }
    if (bid == 0) {
        u32x4* z = (u32x4*)ctl;
        for (int i = tid; i < 65536 / 16; i += NTHREADS) z[i] = (u32x4){0u, 0u, 0u, 0u};
        asm volatile("s_waitcnt vmcnt(0)" ::: "memory");
    }
    __syncthreads();
    grid.sync();
    XcdBarrier xbar = xcd_barrier_post(ctl + 4096, (volatile LAS unsigned*)(lctl + 4));
    if (tid == 0) { const unsigned x = ((unsigned)__builtin_amdgcn_s_getreg((3 << 11) | 20)) & 7u; lctl[0] = x; lctl[1] = __hip_atomic_fetch_add(ctl + 64 * x, 1u, __ATOMIC_RELAXED, __HIP_MEMORY_SCOPE_AGENT); }
    __syncthreads();
    const int vx = __builtin_amdgcn_readfirstlane((int)lctl[0]), rank = __builtin_amdgcn_readfirstlane((int)lctl[1]);
    unsigned char* ws = P.ws;
    bf16_t* WUP = (bf16_t*)(ws + WS_WUP); bf16_t* WDN = (bf16_t*)(ws + WS_WDN); float* X1 = (float*)(ws + WS_X1); bf16_t* HB = (bf16_t*)(ws + WS_HB);
    bf16_t* APRE = (bf16_t*)(ws + WS_APRE); bf16_t* WIN = (bf16_t*)(ws + WS_WIN); bf16_t* WGLU = (bf16_t*)(ws + WS_WGLU); bf16_t* WOUT = (bf16_t*)(ws + WS_WOUT);
    bf16_t* QB = (bf16_t*)(ws + WS_QB); bf16_t* KB = (bf16_t*)(ws + WS_KB); bf16_t* VT = (bf16_t*)(ws + WS_VT); bf16_t* UX = (bf16_t*)(ws + WS_UX);
    bf16_t* MIX = (bf16_t*)(ws + WS_MIX); bf16_t* YG = (bf16_t*)(ws + WS_YG);
    const float* MOD = (const float*)(ws + WS_MOD);

    {
        const int tid = opaque_tid(), lane = tid & 63, wave = __builtin_amdgcn_readfirstlane(tid >> 6); const int lw = rank * NWAVES + wave, lt = rank * NTHREADS + tid; (void)lane; (void)lw; (void)lt;
        constexpr int J_GEMV = 192, J_T8 = (CT_WIN + CT_GLU) / 8;
        constexpr int J_TOTAL = 64 + J_GEMV + J_T8;
        const bool split = G >= 128;
        for (int k_ = 0; ; ++k_) {
            int job;
            if (!split) job = bid + k_ * G;
            else if (bid < 64) { if (k_ > 0) break; job = bid; }
            else job = 64 + (bid - 64) + k_ * (G - 64);
            if (job >= J_TOTAL) break;
            int r = job;
            if (r < 64) { ssm_tables_job(P, r, ldsf, tid); continue; } r -= 64;
            if (r < J_GEMV) { gemv_job(P, r, ldsf, tid); continue; } r -= J_GEMV;
            const int tl = r * 8 + wave;
            if (tl < CT_WIN) convert_tile_w(P, 0, tl, ldsf + wave * (64 * 65), lane); else convert_tile_w(P, 1, tl - CT_WIN, ldsf + wave * (64 * 65), lane);
        }
    }
    GRID_SYNC();
    const int nb = __builtin_amdgcn_readfirstlane((int)__hip_atomic_load(ctl + 64 * vx, __ATOMIC_RELAXED, __HIP_MEMORY_SCOPE_AGENT));
    const int NLW = nb * NWAVES, row_base = vx * 1024, NLT = nb * NTHREADS;

    { const int tid = opaque_tid(), lane = tid & 63, wave = __builtin_amdgcn_readfirstlane(tid >> 6); const int lw = rank * NWAVES + wave, lt = rank * NTHREADS + tid; (void)lane; (void)lw; (void)lt;
    for (int lr = lw; lr < 1024; lr += NLW) { const int row = row_base + lr;
        const int b = row >> 12;
        const f32x4* xr = (const f32x4*)(P.in[I_X] + (size_t)row * DM);
        f32x4 v[8];
#pragma unroll
        for (int j = 0; j < 8; ++j) v[j] = __builtin_nontemporal_load(xr + lane + 64 * j);
        norm_mod_store(v, P.in[I_N1G], MOD + b * 12288 + 0, MOD + b * 12288 + 2048, HB + (size_t)row * DM, lane);
    }
    }
    XCD_SYNC();
    {
        pg8::Gemm g{HB, WIN, NTOK, NQKU, DM, DM, DM}; pg8::XcdOrder S; S.init(NTOK, NQKU, vx, rank, nb);
        pg8::EpiQKU E{QB, KB, UX, P.in[I_QG], P.in[I_KG], C2, EPS};
        pg8::gemm_phase<pg8::EpiQKU, pg8::XcdOrder, true, true>(lds, g, S, E);
    }
    {
        pg8::Gemm g{WIN + (size_t)3072 * DM, HB, 1024, NTOK, DM, DM, DM}; pg8::VtOrder S; S.init(vx, rank, nb);
        pg8::EpiBf16<0> E{VT, NTOK, nullptr, 0, 0, 1.f};
        pg8::gemm_phase<pg8::EpiBf16<0>, pg8::VtOrder, true, true>(lds, g, S, E);
    }
    GRID_SYNC();
    for (;;) {
        const int tid = opaque_tid();
        if (tid == 0) lctl[2] = __hip_atomic_fetch_add(ctl + 64 * 9, 1u, __ATOMIC_RELAXED, __HIP_MEMORY_SCOPE_AGENT);
        __syncthreads();
        const int u0 = __builtin_amdgcn_readfirstlane((int)lctl[2]);
        __syncthreads();
        if (u0 >= 128) break;
        const int sg = u0 >> 1, sb = u0 & 1;
        { int kS = 256; asm volatile("" : "+s"(kS));
          pg8::Gemm g{UX, (const bf16_t*)(ws + WS_WMAT), 64 * 512, 256, kS, 384, 256}; pg8::OneUnit S{u0, sg}; pg8::EpiS E{(float*)(ws + WS_SBUF)};
          pg8::gemm_phase<pg8::EpiS, pg8::OneUnit, true, true>(lds, g, S, E); }
        asm volatile("s_waitcnt vmcnt(0) lgkmcnt(0)" ::: "memory"); __syncthreads();
        ssm_carry_job(P, sg, sb, ldsf, opaque_tid());
        asm volatile("s_waitcnt vmcnt(0) lgkmcnt(0)" ::: "memory"); __syncthreads();
        { int kY = 384; asm volatile("" : "+s"(kY));
          pg8::Gemm g{UX, (const bf16_t*)(ws + WS_AMAT), 64 * 512, 256, kY, 384, 384}; pg8::OneUnit S{u0, sg}; pg8::EpiY E{UX, P.in[I_SD], YG};
          pg8::gemm_phase<pg8::EpiY, pg8::OneUnit, true, true>(lds, g, S, E); }
        asm volatile("s_waitcnt vmcnt(0) lgkmcnt(0)" ::: "memory"); __syncthreads();
        if (opaque_tid() == 0) {
            __builtin_amdgcn_fence(__ATOMIC_RELEASE, "agent"); asm volatile("s_waitcnt vmcnt(0)" ::: "memory");
            __hip_atomic_fetch_add(ctl + 64 * (16 + sb), 1u, __ATOMIC_RELAXED, __HIP_MEMORY_SCOPE_AGENT); }
    }
    {
        const int tid = opaque_tid(), lane = tid & 63;
        float lam, wnd2b;
        { const float a = wave_sum(P.in[I_LQ1][lane] * P.in[I_LK1][lane]), b2 = wave_sum(P.in[I_LQ2][lane] * P.in[I_LK2][lane]); lam = expf(a) - expf(b2) + 0.2f; }
        { float gq = fabsf(P.in[I_QG][lane]), gk = fabsf(P.in[I_KG][lane]);
#pragma unroll
          for (int o_ = 1; o_ < 64; o_ <<= 1) { gq = fmaxf(gq, __shfl_xor(gq, o_)); gk = fmaxf(gk, __shfl_xor(gk, o_)); }
          wnd2b = 2.0f * (8.0f * gq * gk * LOG2E * 1.02f) + 64.0f; }
        bool late_w_done = false;
        for (;;) {
            if (tid == 0) lctl[2] = __hip_atomic_fetch_add(ctl + 64 * 10, 1u, __ATOMIC_RELAXED, __HIP_MEMORY_SCOPE_AGENT);
            __syncthreads();
            const int u = __builtin_amdgcn_readfirstlane((int)lctl[2]);
            __syncthreads();
            if (u >= BATCH * NH * 32) break;
            attn_unit(P, lds, (u & 15) >> 3, u & 7, 31 - (u >> 4), lam, wnd2b, tid);
            if (!late_w_done) LATE_W_ITEM(late_w_done, 15, 0, LATE_SPLIT);
        }
    }
    for (;;) {
        const int tid = opaque_tid();
        if (tid == 0) lctl[2] = __hip_atomic_fetch_add(ctl + 64 * 14, 1u, __ATOMIC_RELAXED, __HIP_MEMORY_SCOPE_AGENT);
        __syncthreads();
        const int t = __builtin_amdgcn_readfirstlane((int)lctl[2]);
        __syncthreads();
        if (t >= 128) break;
        const int pm = t >> 2, pn = t & 3;
        if (tid == 0) {
            while (__hip_atomic_load(ctl + 64 * (16 + (pm >> 4)), __ATOMIC_RELAXED, __HIP_MEMORY_SCOPE_AGENT) < 64u) __builtin_amdgcn_s_sleep(8);
            __builtin_amdgcn_fence(__ATOMIC_ACQUIRE, "agent"); asm volatile("s_waitcnt vmcnt(0)" ::: "memory"); }
        __syncthreads();
        { pg8::Gemm g{YG, WGLU, NTOK, 1024, 1024, 1024, 1024}; pg8::OneUnit S{pm, pn}; pg8::EpiGlu E{YG, 1024, P.in[I_BGLU], MIX + 1024, 2048};
          pg8::gemm_phase<pg8::EpiGlu, pg8::OneUnit, true, true>(lds, g, S, E); }
        asm volatile("s_waitcnt vmcnt(0) lgkmcnt(0)" ::: "memory"); __syncthreads();
    }
    { bool late_done = false;
      while (!late_done) LATE_W_ITEM(late_done, 18, LATE_SPLIT, 416);
      late_done = false; while (!late_done) LATE_W_ITEM(late_done, 15, 0, LATE_SPLIT); }
    GRID_SYNC();
    {
        pg8::Gemm g{MIX, WOUT, NTOK, DM, DM, DM, DM}; pg8::XcdOrder S; S.init(NTOK, DM, vx, rank, nb);
        pg8::EpiResOutB E{P.in[I_X], MOD + 4096, (bf16_t*)X1, DM};
        pg8::gemm_phase<pg8::EpiResOutB, pg8::XcdOrder, true, true>(lds, g, S, E);
    }
    XCD_SYNC();
    { const int tid = opaque_tid(), lane = tid & 63, wave = __builtin_amdgcn_readfirstlane(tid >> 6); const int lw = rank * NWAVES + wave, lt = rank * NTHREADS + tid; (void)lane; (void)lw; (void)lt;
    for (int lr = lw; lr < 1024; lr += NLW) { const int row = row_base + lr;
        const int b = row >> 12;
        const u32x2* x1r = (const u32x2*)((const bf16_t*)X1 + (size_t)row * DM);
        f32x4 v[8];
#pragma unroll
        for (int j = 0; j < 8; ++j) { const u32x2 q = x1r[lane + 64 * j]; v[j] = (f32x4){bflo(q.x), bfhi(q.x), bflo(q.y), bfhi(q.y)}; }
        norm_mod_store(v, P.in[I_N2G], MOD + b * 12288 + 6144, MOD + b * 12288 + 8192, HB + (size_t)row * DM, lane);
    }
    }
    XCD_SYNC();
    bf16_t* ACT = APRE;
    {
        pg8::Gemm g{HB, WUP, NTOK, 2 * DFF, DM, DM, DM}; pg8::XcdOrder S; S.init(NTOK, 2 * DFF, vx, rank, nb);
        pg8::EpiUpAct E{ACT, (bf16_t*)(ws + WS_SIDEA), (bf16_t*)(ws + WS_SIDEB), P.in[I_CONVW], P.in[I_CONVB], DFF};
        pg8::gemm_phase<pg8::EpiUpAct, pg8::XcdOrder, true, true>(lds, g, S, E);
        WDN_QUEUE();
    }
    GRID_SYNC();
    { const int tid = opaque_tid(); const int lt = rank * NTHREADS + tid;
    for (int lj = lt; lj < 16 * 704; lj += NLT) {
        const int fv = lj % 704, blk = vx * 16 + lj / 704, f0 = fv * 8, t0 = blk * 64;
        const bf16_t* sA = (const bf16_t*)(ws + WS_SIDEA); const bf16_t* sB = (const bf16_t*)(ws + WS_SIDEB) + (size_t)blk * 4 * DFF + f0;
        u32x4 pm2 = {0u, 0u, 0u, 0u}, pm1 = {0u, 0u, 0u, 0u};
        if ((t0 & 4095) != 0) { const bf16_t* p = sA + (size_t)(blk - 1) * 2 * DFF + f0; pm2 = *(const u32x4*)p; pm1 = *(const u32x4*)(p + DFF); }
        const u32x4 qa0 = *(const u32x4*)sB, qg0 = *(const u32x4*)(sB + DFF), qa1 = *(const u32x4*)(sB + 2 * DFF), qg1 = *(const u32x4*)(sB + 3 * DFF);
        float am2[8], am1[8], a0[8], g0[8], a1[8], g1[8], o0[8], o1[8];
#define UNPK(dst, V_) do { dst[0] = bflo(V_.x); dst[1] = bfhi(V_.x); dst[2] = bflo(V_.y); dst[3] = bfhi(V_.y); dst[4] = bflo(V_.z); dst[5] = bfhi(V_.z); dst[6] = bflo(V_.w); dst[7] = bfhi(V_.w); } while (0)
        UNPK(am2, pm2); UNPK(am1, pm1); UNPK(a0, qa0); UNPK(g0, qg0); UNPK(a1, qa1); UNPK(g1, qg1);
#undef UNPK
#pragma unroll
        for (int h = 0; h < 2; ++h) { const f32x4 c0 = *(const f32x4*)(P.in[I_CONVW] + f0 + 4 * h), c1 = *(const f32x4*)(P.in[I_CONVW] + DFF + f0 + 4 * h), c2 = *(const f32x4*)(P.in[I_CONVW] + 2 * DFF + f0 + 4 * h), bb = *(const f32x4*)(P.in[I_CONVB] + f0 + 4 * h);
#pragma unroll
            for (int e4 = 0; e4 < 4; ++e4) { const int e = 4 * h + e4;
                o0[e] = gelu_tanh(c0[e4] * am2[e] + c1[e4] * am1[e] + c2[e4] * a0[e] + bb[e4]) * g0[e];
                o1[e] = gelu_tanh(c0[e4] * am1[e] + c1[e4] * a0[e] + c2[e4] * a1[e] + bb[e4]) * g1[e]; } }
        u32x4 w0, w1; w0.x = pk2(o0[0], o0[1]); w0.y = pk2(o0[2], o0[3]); w0.z = pk2(o0[4], o0[5]); w0.w = pk2(o0[6], o0[7]);
        w1.x = pk2(o1[0], o1[1]); w1.y = pk2(o1[2], o1[3]); w1.z = pk2(o1[4], o1[5]); w1.w = pk2(o1[6], o1[7]);
        *(u32x4*)(ACT + (size_t)t0 * DFF + f0) = w0; *(u32x4*)(ACT + (size_t)(t0 + 1) * DFF + f0) = w1;
    }
    }
    XCD_SYNC();

    {
        pg8::Gemm g{ACT, WDN, NTOK, DM, DFF, DFF, DFF}; pg8::XcdOrder S; S.init(NTOK, DM, vx, rank, nb);
        pg8::EpiResInB E{(const bf16_t*)X1, MOD + 10240, P.out, DM};
        pg8::gemm_phase<pg8::EpiResInB, pg8::XcdOrder, true, true>(lds, g, S, E);
    }
}

extern "C" void kernel_launch(void* const* d_in, const int* in_sizes, int n_in, void* d_out, int out_size, void* d_ws, size_t ws_size, hipStream_t stream) {
    static int grid_blocks = 0;
    if (grid_blocks == 0) {
        if (n_in != 29 || ws_size < WS_END) { fprintf(stderr, "kernel_launch: unexpected n_in %d or ws_size %zu\n", n_in, ws_size); grid_blocks = -1; return; }
        int dev = 0, cus = 0, per_cu = 0;
        hipGetDevice(&dev);
        hipDeviceGetAttribute(&cus, hipDeviceAttributeMultiprocessorCount, dev);
        if (hipFuncSetAttribute((const void*)fwd_kernel, hipFuncAttributeMaxDynamicSharedMemorySize, LDS_BYTES) != hipSuccess) fprintf(stderr, "hipFuncSetAttribute failed\n");
        if (hipOccupancyMaxActiveBlocksPerMultiprocessor(&per_cu, (const void*)fwd_kernel, NTHREADS, LDS_BYTES) != hipSuccess || per_cu < 1) { fprintf(stderr, "occupancy query: %d\n", per_cu); per_cu = 1; }
        (void)hipGetLastError();
        grid_blocks = cus;
    }
    if (grid_blocks < 0) return;
    Params p{};
    for (int i = 0; i < 29; ++i) p.in[i] = (const float*)d_in[i];
    p.out = (float*)d_out; p.ws = (unsigned char*)d_ws;
    void* args[] = {&p};
    hipError_t e = hipLaunchCooperativeKernel((const void*)fwd_kernel, dim3(grid_blocks), dim3(NTHREADS), args, LDS_BYTES, stream);
    if (e != hipSuccess) fprintf(stderr, "cooperative launch failed: %s (grid %d)\n", hipGetErrorString(e), grid_blocks);
}
```

```cpp
#include <hip/hip_runtime.h>
#include <hip/hip_cooperative_groups.h>
#include <cstdio>
#include <cstdint>
namespace cg = cooperative_groups;
namespace pg8 {
#define PG8_LAS __attribute__((address_space(3)))
typedef unsigned short bf16_t;
typedef short bf16x8 __attribute__((ext_vector_type(8)));
typedef float f32x4 __attribute__((ext_vector_type(4)));
typedef unsigned u32x4 __attribute__((ext_vector_type(4)));
constexpr int BM = 256, BK = 64, HALF = 128, HTB = HALF * BK * 2  , STAGE_BYTES = 8 * HTB, NXCD = 8, WGM = 8;

__host__ __device__ __forceinline__ int lds_byte(int r, int c) { const int st = (r >> 4) * 2 + (c >> 5), rr = r & 15, cc = c & 31, ob = rr * 64 + cc * 2; return st * 1024 + (ob ^ (((ob >> 9) & 1) << 5)); }
__host__ __device__ __forceinline__ void stage_rc(int b, int& R, int& C) { const int st = b / 1024, sb = b % 1024, swz = sb ^ (((sb >> 9) & 1) << 5); R = (st >> 1) * 16 + swz / 64; C = (st & 1) * 32 + (swz % 64) / 2; }
__host__ __device__ __forceinline__ int perm32(int rho) { const int n = rho >> 4, i = rho & 15; return 8 * (i >> 2) + 4 * n + (i & 3); }

struct Unit { int pm, pn; };
struct Gemm { const bf16_t* A; const bf16_t* Bt; int M, N, K, lda, ldb; };

struct StaticOrder {
    int nM, nN, nwg, G, c;
    __host__ __device__ void init(int M, int N, int G_, int c_) { nM = M / BM; nN = N / BM; nwg = nM * nN; G = G_; c = c_; }
    __host__ __device__ bool next(int i, Unit& u) const {
        const long L = (long)i * G + c; if (L >= nwg) return false;
        int wgid = (int)L; { const int q = nwg / NXCD, r = nwg % NXCD, xcd = wgid % NXCD, off = wgid / NXCD; wgid = (xcd < r ? xcd * (q + 1) : r * (q + 1) + (xcd - r) * q) + off; }
        const int nig = WGM * nN, gid = wgid / nig, fm = gid * WGM, gsz = (nM - fm) < WGM ? (nM - fm) : WGM;
        u.pm = fm + ((wgid % nig) % gsz); u.pn = (wgid % nig) / gsz; return true;
    }
    __device__ __forceinline__ void a_ready(const Unit&) const {}
    __device__ __forceinline__ void done(const Unit&) const {}
};

__device__ __forceinline__ unsigned cvt_pk_bf16(float lo, float hi) { unsigned r; asm volatile("v_cvt_pk_bf16_f32 %0, %1, %2" : "=v"(r) : "v"(lo), "v"(hi)); return r; }
typedef float f32x2 __attribute__((ext_vector_type(2)));
__device__ __forceinline__ f32x2 gelu_pk(f32x2 v) {
    const f32x2 av = __builtin_elementwise_abs(v), d = av * 0.2316418882f + 1.0f;
    f32x2 t; t.x = __builtin_amdgcn_rcpf(d.x); t.y = __builtin_amdgcn_rcpf(d.y);
    f32x2 q = t * 0.5307027145f + (-0.7265760135f); q = q * t + 0.7107068705f; q = q * t + (-0.142248368f); q = q * t + 0.127414796f; q = q * t;
    const f32x2 s = (v * v) * (-0.72134752044f);
    f32x2 e; e.x = __builtin_amdgcn_exp2f(s.x); e.y = __builtin_amdgcn_exp2f(s.y);
    const f32x2 m = v * (q * e), r = v - m;
    f32x2 o; o.x = v.x < 0.f ? m.x : r.x; o.y = v.y < 0.f ? m.y : r.y; return o;
}

template <int ACT  > struct EpiBf16 {
    static constexpr bool PERM = true, AFTER_DRAIN = false; static_assert(ACT == 0 || ACT == 1, "EpiBf16: ACT is 0 (none) or 1 (gelu_pk)");
    bf16_t* O; int ldc; const float* bias; int split_cols; size_t split_stride; float scale0;
    __device__ __forceinline__ void operator()(const f32x4 (&acc)[2][2][4][2], const Unit& u, int wr, int wc, int fr, int fq) const {
        const int row0 = u.pm * BM + wr * 64 + fr; int colt = u.pn * BM; bf16_t* base = O;
        float sc = 1.f; if (split_cols) { const int t = colt / split_cols; base += (size_t)t * split_stride; colt -= t * split_cols; if (t == 0) sc = scale0; }
        const int col0 = colt + wc * 32 + 8 * fq, bcol0 = u.pn * BM + wc * 32 + 8 * fq;
        f32x4 bv[2][2];
#pragma unroll
        for (int bj = 0; bj < 2; ++bj)
#pragma unroll
            for (int n = 0; n < 2; ++n) bv[bj][n] = bias ? *(const f32x4*)(bias + bcol0 + bj * HALF + 4 * n) : (f32x4){0.f, 0.f, 0.f, 0.f};
#pragma unroll
        for (int ai = 0; ai < 2; ++ai)
#pragma unroll
            for (int m = 0; m < 4; ++m) { bf16_t* rowp = base + (size_t)(row0 + ai * HALF + m * 16) * ldc + col0;
#pragma unroll
                for (int bj = 0; bj < 2; ++bj) { f32x4 v0 = acc[ai][bj][m][0] + bv[bj][0], v1 = acc[ai][bj][m][1] + bv[bj][1];
                    if (ACT == 1) { f32x2 a = gelu_pk((f32x2){v0[0], v0[1]}), b = gelu_pk((f32x2){v0[2], v0[3]}), c = gelu_pk((f32x2){v1[0], v1[1]}), d = gelu_pk((f32x2){v1[2], v1[3]});
                        v0 = (f32x4){a.x, a.y, b.x, b.y}; v1 = (f32x4){c.x, c.y, d.x, d.y}; }
                    v0 = v0 * sc; v1 = v1 * sc; u32x4 w; w.x = cvt_pk_bf16(v0[0], v0[1]); w.y = cvt_pk_bf16(v0[2], v0[3]); w.z = cvt_pk_bf16(v1[0], v1[1]); w.w = cvt_pk_bf16(v1[2], v1[3]);
                    *(u32x4*)(rowp + bj * HALF) = w; } }
    }
};
template <class Epi, class Sched, bool ALIGN_EPI = false, bool SP2 = false>
__device__ __forceinline__ void gemm_phase(PG8_LAS unsigned char* lds, const Gemm g, const Sched& S, const Epi& E) {
    int tid_o = threadIdx.x; asm volatile("" : "+v"(tid_o));
    const int tid = tid_o, wid = __builtin_amdgcn_readfirstlane(tid >> 6), lane = tid & 63, wr = wid >> 2, wc = wid & 3, fr = lane & 15, fq = lane >> 4;
    const int K = g.K, nt = K / BK;
    unsigned voffA[2], voffB[2];
#pragma unroll
    for (int i = 0; i < 2; ++i) { int R, C; stage_rc(tid * 16 + i * 8192, R, C); const int Rb = Epi::PERM ? ((R & ~31) + perm32(R & 31)) : R;
        voffA[i] = (unsigned)(R * g.lda + C) * 2u; voffB[i] = (unsigned)(Rb * g.ldb + C) * 2u; }
    const size_t kstep = (size_t)(BK * 2);
    const size_t hstepA = (size_t)HALF * g.lda * 2, hstepB = (size_t)HALF * g.ldb * 2;
    const size_t tstepA = 2 * hstepA, tstepB = 2 * hstepB;
    const unsigned ldsw = (unsigned)wid * 1024u;
    const int aoff = lds_byte(wr * 64 + fr, fq * 8), boff = lds_byte(wc * 32 + fr, fq * 8);
#define PG8_SA(b, h) (((b) * 2 + (h)) * HTB)
#define PG8_SB(b, h) ((4 + (b) * 2 + (h)) * HTB)
#define PG8_STAGE(bufoff, gbase, voff) do { _Pragma("unroll") for (int _i = 0; _i < 2; ++_i) \
        __builtin_amdgcn_global_load_lds((const unsigned*)((const char*)(gbase) + (voff)[_i]), (PG8_LAS unsigned*)(lds + (bufoff) + ldsw + _i * 8192), 16, 0, 0); } while (0)
#define PG8_LDA(dst, b, h) do { _Pragma("unroll") for (int m = 0; m < 4; ++m) _Pragma("unroll") for (int k = 0; k < 2; ++k) dst[m][k] = *(const PG8_LAS bf16x8*)(lds + PG8_SA(b, h) + aoff + m * 2048 + k * 1024); } while (0)
#define PG8_LDB(dst, b, h) do { _Pragma("unroll") for (int n = 0; n < 2; ++n) _Pragma("unroll") for (int k = 0; k < 2; ++k) dst[n][k] = *(const PG8_LAS bf16x8*)(lds + PG8_SB(b, h) + boff + n * 2048 + k * 1024); } while (0)
#define PG8_MMA(ai, bj, At, Bt) do { __builtin_amdgcn_s_setprio(1); _Pragma("unroll") for (int m = 0; m < 4; ++m) _Pragma("unroll") for (int n = 0; n < 2; ++n) _Pragma("unroll") for (int k = 0; k < 2; ++k) \
        acc[ai][bj][m][n] = __builtin_amdgcn_mfma_f32_16x16x32_bf16(Bt[n][k], At[m][k], acc[ai][bj][m][n], 0, 0, 0); __builtin_amdgcn_s_setprio(0); } while (0)
#define PG8_WAIT_V(n) asm volatile("s_waitcnt vmcnt(" #n ")" ::: "memory")
#define PG8_WAIT_L(n) asm volatile("s_waitcnt lgkmcnt(" #n ")" ::: "memory")
#define PG8_BAR __builtin_amdgcn_s_barrier()
#define PG8_SCHED __builtin_amdgcn_sched_barrier(0)
    Unit cur, nxt; int ui = 0;
    if (!S.next(0, cur)) return;
    f32x4 acc[2][2][4][2];
#pragma unroll
    for (int a = 0; a < 2; ++a)
#pragma unroll
        for (int b = 0; b < 2; ++b)
#pragma unroll
            for (int m = 0; m < 4; ++m)
#pragma unroll
                for (int n = 0; n < 2; ++n) acc[a][b][m][n] = (f32x4){0.f, 0.f, 0.f, 0.f};
    bf16x8 At[4][2], B0[2][2], B1[2][2];
    const char* cA = (const char*)g.A + (size_t)cur.pm * tstepA; const char* cB = (const char*)g.Bt + (size_t)cur.pn * tstepB;
    S.a_ready(cur);
    if constexpr (SP2) {
        PG8_STAGE(PG8_SB(0, 0), cB, voffB); PG8_STAGE(PG8_SB(0, 1), cB + hstepB, voffB); PG8_STAGE(PG8_SA(0, 0), cA, voffA); PG8_STAGE(PG8_SA(0, 1), cA + hstepA, voffA);
        if (wr == 1) PG8_BAR;
        PG8_WAIT_V(2); PG8_BAR;
        PG8_STAGE(PG8_SB(1, 0), cB + kstep, voffB); PG8_STAGE(PG8_SA(1, 0), cA + kstep, voffA); PG8_STAGE(PG8_SB(1, 1), cB + hstepB + kstep, voffB);
        PG8_WAIT_V(6); PG8_BAR;
    } else {
        PG8_STAGE(PG8_SB(0, 0), cB, voffB); PG8_STAGE(PG8_SA(0, 0), cA, voffA); PG8_STAGE(PG8_SB(0, 1), cB + hstepB, voffB); PG8_STAGE(PG8_SA(0, 1), cA + hstepA, voffA);
        if (wr == 1) PG8_BAR;
        PG8_WAIT_V(4); PG8_BAR;
        PG8_STAGE(PG8_SB(1, 0), cB + kstep, voffB); PG8_STAGE(PG8_SA(1, 0), cA + kstep, voffA); PG8_STAGE(PG8_SB(1, 1), cB + hstepB + kstep, voffB);
        PG8_WAIT_V(6); PG8_BAR;
    }
    for (;;) {
        const bool has_next = S.next(ui + 1, nxt);
        const char* nA = has_next ? (const char*)g.A + (size_t)nxt.pm * tstepA : cA; const char* nB = has_next ? (const char*)g.Bt + (size_t)nxt.pn * tstepB : cB;
        for (int t = 0; t < nt; t += 2) {
            const bool last = (t == nt - 2);
            const char* a1 = cA + (size_t)(t + 1) * kstep;
            const char* a2 = last ? nA : cA + (size_t)(t + 2) * kstep; const char* b2 = last ? nB : cB + (size_t)(t + 2) * kstep;
            const char* a3 = a2 + kstep; const char* b3 = b2 + kstep;
            if (last && has_next) S.a_ready(nxt);
            if constexpr (SP2) {
            PG8_LDB(B0, 0, 0); PG8_LDB(B1, 0, 1); PG8_SCHED; PG8_LDA(At, 0, 0); PG8_STAGE(PG8_SA(1, 1), a1 + hstepA, voffA);
            PG8_WAIT_V(8); PG8_WAIT_L(0); PG8_BAR; PG8_MMA(0, 0, At, B0); PG8_MMA(0, 1, At, B1); PG8_BAR; PG8_SCHED;
            PG8_LDA(At, 0, 1); PG8_STAGE(PG8_SB(0, 0), b2, voffB); PG8_STAGE(PG8_SB(0, 1), b2 + hstepB, voffB); PG8_STAGE(PG8_SA(0, 0), a2, voffA);
            PG8_WAIT_V(8); PG8_WAIT_L(0); PG8_BAR; PG8_MMA(1, 0, At, B0); PG8_MMA(1, 1, At, B1); PG8_BAR; PG8_SCHED;
            PG8_LDB(B0, 1, 0); PG8_LDB(B1, 1, 1); PG8_SCHED; PG8_LDA(At, 1, 0); PG8_STAGE(PG8_SA(0, 1), a2 + hstepA, voffA);
            PG8_WAIT_V(8); PG8_WAIT_L(0); PG8_BAR; PG8_MMA(0, 0, At, B0); PG8_MMA(0, 1, At, B1); PG8_BAR; PG8_SCHED;
            PG8_LDA(At, 1, 1); PG8_STAGE(PG8_SB(1, 0), b3, voffB); PG8_STAGE(PG8_SB(1, 1), b3 + hstepB, voffB); PG8_STAGE(PG8_SA(1, 0), a3, voffA);
            PG8_WAIT_V(8); PG8_WAIT_L(0); PG8_BAR; PG8_MMA(1, 0, At, B0); PG8_MMA(1, 1, At, B1); PG8_BAR; PG8_SCHED;
            } else {
            PG8_LDB(B0, 0, 0); PG8_SCHED; PG8_LDA(At, 0, 0); PG8_STAGE(PG8_SA(1, 1), a1 + hstepA, voffA);
            PG8_WAIT_L(8); PG8_BAR; PG8_WAIT_L(0); PG8_MMA(0, 0, At, B0); PG8_BAR; PG8_SCHED;
            PG8_LDB(B1, 0, 1); PG8_STAGE(PG8_SB(0, 0), b2, voffB);
            PG8_BAR; PG8_WAIT_L(0); PG8_MMA(0, 1, At, B1); PG8_BAR;
            PG8_LDA(At, 0, 1); PG8_STAGE(PG8_SA(0, 0), a2, voffA);
            PG8_BAR; PG8_WAIT_L(0); PG8_MMA(1, 0, At, B0); PG8_BAR; PG8_SCHED;
            PG8_STAGE(PG8_SB(0, 1), b2 + hstepB, voffB);
            PG8_WAIT_V(6); PG8_BAR; PG8_MMA(1, 1, At, B1); PG8_BAR;
            PG8_LDB(B0, 1, 0); PG8_SCHED; PG8_LDA(At, 1, 0); PG8_STAGE(PG8_SA(0, 1), a2 + hstepA, voffA);
            PG8_WAIT_L(8); PG8_BAR; PG8_WAIT_L(0); PG8_MMA(0, 0, At, B0); PG8_BAR; PG8_SCHED;
            PG8_LDB(B1, 1, 1); PG8_STAGE(PG8_SB(1, 0), b3, voffB);
            PG8_BAR; PG8_WAIT_L(0); PG8_MMA(0, 1, At, B1); PG8_BAR;
            PG8_LDA(At, 1, 1); PG8_STAGE(PG8_SA(1, 0), a3, voffA);
            PG8_BAR; PG8_WAIT_L(0); PG8_MMA(1, 0, At, B0); PG8_BAR; PG8_SCHED;
            PG8_STAGE(PG8_SB(1, 1), b3 + hstepB, voffB);
            PG8_WAIT_V(6); PG8_BAR; PG8_MMA(1, 1, At, B1); PG8_BAR;
            }
        }
        if constexpr (ALIGN_EPI) { if (wr == 0) PG8_BAR; }
        if constexpr (!Epi::AFTER_DRAIN) { E(acc, cur, wr, wc, fr, fq); S.done(cur); }
        if (!has_next) break;
#pragma unroll
        for (int a = 0; a < 2; ++a)
#pragma unroll
            for (int b = 0; b < 2; ++b)
#pragma unroll
                for (int m = 0; m < 4; ++m)
#pragma unroll
                    for (int n = 0; n < 2; ++n) acc[a][b][m][n] = (f32x4){0.f, 0.f, 0.f, 0.f};
        cur = nxt; cA = nA; cB = nB; ++ui;
        if constexpr (ALIGN_EPI) { if (wr == 1) PG8_BAR; }
    }
    PG8_WAIT_V(0);
    if constexpr (!ALIGN_EPI) { if (wr == 0) PG8_BAR; }
    PG8_BAR;
    if constexpr (Epi::AFTER_DRAIN) { E.fused(acc, cur, wr, wc, fr, fq, lds, wid, lane); S.done(cur); }
#undef PG8_SA
#undef PG8_SB
#undef PG8_STAGE
#undef PG8_LDA
#undef PG8_LDB
#undef PG8_MMA
#undef PG8_WAIT_V
#undef PG8_WAIT_L
#undef PG8_BAR
#undef PG8_SCHED
}
}

namespace pg8 {
struct EpiF32 {
    static constexpr bool PERM = true, AFTER_DRAIN = false;
    float* O; int ldc;
    __device__ __forceinline__ void operator()(const f32x4 (&acc)[2][2][4][2], const Unit& u, int wr, int wc, int fr, int fq) const {
        const int row0 = u.pm * BM + wr * 64 + fr, col0 = u.pn * BM + wc * 32 + 8 * fq;
#pragma unroll
        for (int ai = 0; ai < 2; ++ai)
#pragma unroll
            for (int m = 0; m < 4; ++m) { float* rowp = O + (size_t)(row0 + ai * HALF + m * 16) * ldc + col0;
#pragma unroll
                for (int bj = 0; bj < 2; ++bj) { *(f32x4*)(rowp + bj * HALF) = acc[ai][bj][m][0]; *(f32x4*)(rowp + bj * HALF + 4) = acc[ai][bj][m][1]; } }
    }
};

struct XcdOrder {
    int ppx, ntile, rank, nb, pm0;
    __device__ void init(int M, int N, int vx, int rank_, int nb_) { ppx = (M / BM) / NXCD; ntile = ppx * (N / BM); rank = rank_; nb = nb_; pm0 = vx * ppx; }
    __device__ bool next(int i, Unit& u) const { const int t = rank + i * nb; if (t >= ntile) return false; u.pm = pm0 + t % ppx; u.pn = t / ppx; return true; }
    __device__ __forceinline__ void a_ready(const Unit&) const {}
    __device__ __forceinline__ void done(const Unit&) const {}
};
struct VtOrder {
    int vx, r2, nb2;
    __device__ void init(int vx_, int rank, int nb) { vx = vx_; r2 = rank - nb / 2; nb2 = nb - nb / 2; }
    __device__ bool next(int i, Unit& u) const { if (r2 < 0) return false; const int t = r2 + i * nb2; if (t >= 16) return false; u.pm = t & 3; u.pn = vx * 4 + (t >> 2); return true; }
    __device__ __forceinline__ void a_ready(const Unit&) const {}
    __device__ __forceinline__ void done(const Unit&) const {}
};
struct EpiUp {
    static constexpr bool PERM = true, AFTER_DRAIN = false;
    bf16_t* O; int ldc; bf16_t* side; int acols;
    __device__ __forceinline__ void operator()(const f32x4 (&acc)[2][2][4][2], const Unit& u, int wr, int wc, int fr, int fq) const {
        const int row0 = u.pm * BM + wr * 64 + fr, col0 = u.pn * BM + wc * 32 + 8 * fq;
#pragma unroll
        for (int ai = 0; ai < 2; ++ai)
#pragma unroll
            for (int m = 0; m < 4; ++m) { const int row = row0 + ai * HALF + m * 16; bf16_t* rowp = O + (size_t)row * ldc + col0;
#pragma unroll
                for (int bj = 0; bj < 2; ++bj) { const f32x4 v0 = acc[ai][bj][m][0], v1 = acc[ai][bj][m][1];
                    u32x4 w; w.x = cvt_pk_bf16(v0[0], v0[1]); w.y = cvt_pk_bf16(v0[2], v0[3]); w.z = cvt_pk_bf16(v1[0], v1[1]); w.w = cvt_pk_bf16(v1[2], v1[3]);
                    *(u32x4*)(rowp + bj * HALF) = w;
                    if ((row & 1023) >= 1022 && col0 + bj * HALF < acols) *(u32x4*)(side + ((size_t)(row >> 10) * 2 + (row & 1)) * acols + col0 + bj * HALF) = w; } }
    }
};

struct DiagOrder {
    int vb, nvb;
    __device__ bool next(int i, Unit& u) const { const int t = vb + i * nvb; if (t >= 128) return false; u.pm = t; u.pn = t >> 1; return true; }
    __device__ __forceinline__ void a_ready(const Unit&) const {}
    __device__ __forceinline__ void done(const Unit&) const {}
};
struct EpiS {
    static constexpr bool PERM = true, AFTER_DRAIN = false;
    float* S;
    __device__ __forceinline__ void operator()(const f32x4 (&acc)[2][2][4][2], const Unit& u, int wr, int wc, int fr, int fq) const {
        const int row0 = u.pm * BM + wr * 64 + fr, col0 = wc * 32 + 8 * fq;
#pragma unroll
        for (int ai = 0; ai < 2; ++ai)
#pragma unroll
            for (int m = 0; m < 4; ++m) { float* rowp = S + (size_t)(row0 + ai * HALF + m * 16) * 128 + col0; *(f32x4*)rowp = acc[ai][0][m][0]; *(f32x4*)(rowp + 4) = acc[ai][0][m][1]; }
    }
};
struct EpiY {
    static constexpr bool PERM = true, AFTER_DRAIN = false;
    const bf16_t* UX; const float* dsk; bf16_t* YG;
    __device__ __forceinline__ void operator()(const f32x4 (&acc)[2][2][4][2], const Unit& u, int wr, int wc, int fr, int fq) const {
        const int g = u.pn, row0 = u.pm * BM + wr * 64 + fr;
#pragma unroll
        for (int bj = 0; bj < 2; ++bj) {
            const int col = bj * HALF + wc * 32 + 8 * fq, t = col >> 4, c0 = col & 15;
            const f32x4 d0 = *(const f32x4*)(dsk + g * 16 + c0), d1 = *(const f32x4*)(dsk + g * 16 + c0 + 4);
            u32x4 uwv[2][4];
#pragma unroll
            for (int ai = 0; ai < 2; ++ai)
#pragma unroll
                for (int m = 0; m < 4; ++m) uwv[ai][m] = *(const u32x4*)(UX + (size_t)(row0 + ai * HALF + m * 16) * 384 + col);
#pragma unroll
            for (int ai = 0; ai < 2; ++ai)
#pragma unroll
                for (int m = 0; m < 4; ++m) {
                    const int row = row0 + ai * HALF + m * 16, seq = row - g * 512;
                    const u32x4 uw = uwv[ai][m];
                    const f32x4 a0 = acc[ai][bj][m][0], a1 = acc[ai][bj][m][1];
                    float y[8];
                    y[0] = a0[0] + d0[0] * __builtin_bit_cast(float, uw.x << 16); y[1] = a0[1] + d0[1] * __builtin_bit_cast(float, uw.x & 0xffff0000u);
                    y[2] = a0[2] + d0[2] * __builtin_bit_cast(float, uw.y << 16); y[3] = a0[3] + d0[3] * __builtin_bit_cast(float, uw.y & 0xffff0000u);
                    y[4] = a1[0] + d1[0] * __builtin_bit_cast(float, uw.z << 16); y[5] = a1[1] + d1[1] * __builtin_bit_cast(float, uw.z & 0xffff0000u);
                    y[6] = a1[2] + d1[2] * __builtin_bit_cast(float, uw.w << 16); y[7] = a1[3] + d1[3] * __builtin_bit_cast(float, uw.w & 0xffff0000u);
#pragma unroll
                    for (int e = 0; e < 8; ++e) { const float x = y[e], q = 0.7978845608028654f * (x + 0.044715f * x * x * x); y[e] = x * __builtin_amdgcn_rcpf(1.0f + __builtin_amdgcn_exp2f(-2.885390081777927f * q)); }
                    u32x4 w; w.x = cvt_pk_bf16(y[0], y[1]); w.y = cvt_pk_bf16(y[2], y[3]); w.z = cvt_pk_bf16(y[4], y[5]); w.w = cvt_pk_bf16(y[6], y[7]);
                    { bf16_t* yp = YG + ((size_t)seq * 16 + t) * 1024 + g * 16 + c0; asm volatile("global_store_dwordx4 %0, %1, off sc1\n\ts_nop 1" :: "v"(yp), "v"(w) : "memory"); }
                }
            asm volatile("" ::: "memory");
        }
    }
};

struct EpiRes {
    static constexpr bool PERM = true, AFTER_DRAIN = false;
    const float* base; const float* gate; float* O; int ldc;
    __device__ __forceinline__ void operator()(const f32x4 (&acc)[2][2][4][2], const Unit& u, int wr, int wc, int fr, int fq) const {
        const int row0 = u.pm * BM + wr * 64 + fr, col0 = u.pn * BM + wc * 32 + 8 * fq; const float* gp = gate + ((u.pm * BM) >> 12) * 12288 + col0;
        f32x4 gv[2][2];
#pragma unroll
        for (int bj = 0; bj < 2; ++bj) { gv[bj][0] = *(const f32x4*)(gp + bj * HALF); gv[bj][1] = *(const f32x4*)(gp + bj * HALF + 4); }
#pragma unroll
        for (int ai = 0; ai < 2; ++ai) {
            f32x4 xv[4][2][2];
#pragma unroll
            for (int m = 0; m < 4; ++m) { const size_t off = (size_t)(row0 + ai * HALF + m * 16) * ldc + col0;
#pragma unroll
                for (int bj = 0; bj < 2; ++bj) { xv[m][bj][0] = *(const f32x4*)(base + off + bj * HALF); xv[m][bj][1] = *(const f32x4*)(base + off + bj * HALF + 4); } }
#pragma unroll
            for (int m = 0; m < 4; ++m) { const size_t off = (size_t)(row0 + ai * HALF + m * 16) * ldc + col0;
#pragma unroll
                for (int bj = 0; bj < 2; ++bj) { *(f32x4*)(O + off + bj * HALF) = xv[m][bj][0] + gv[bj][0] * acc[ai][bj][m][0]; *(f32x4*)(O + off + bj * HALF + 4) = xv[m][bj][1] + gv[bj][1] * acc[ai][bj][m][1]; } }
            asm volatile("" ::: "memory");
        }
    }
};
struct EpiGlu {
    static constexpr bool PERM = true, AFTER_DRAIN = false;
    const bf16_t* Y; int ldy; const float* bias; bf16_t* O; int ldo;
    __device__ __forceinline__ void operator()(const f32x4 (&acc)[2][2][4][2], const Unit& u, int wr, int wc, int fr, int fq) const {
        const int row0 = u.pm * BM + wr * 64 + fr, col0 = u.pn * BM + wc * 32 + 8 * fq;
        f32x4 bv[2][2];
#pragma unroll
        for (int bj = 0; bj < 2; ++bj) { bv[bj][0] = *(const f32x4*)(bias + col0 + bj * HALF); bv[bj][1] = *(const f32x4*)(bias + col0 + bj * HALF + 4); }
#pragma unroll
        for (int ai = 0; ai < 2; ++ai) {
            u32x4 ywv[4][2];
#pragma unroll
            for (int m = 0; m < 4; ++m)
#pragma unroll
                for (int bj = 0; bj < 2; ++bj) ywv[m][bj] = *(const u32x4*)(Y + (size_t)(row0 + ai * HALF + m * 16) * ldy + col0 + bj * HALF);
#pragma unroll
            for (int m = 0; m < 4; ++m) { const int row = row0 + ai * HALF + m * 16;
#pragma unroll
                for (int bj = 0; bj < 2; ++bj) { const int col = col0 + bj * HALF; const u32x4 yw = ywv[m][bj];
                    const f32x4 z0 = acc[ai][bj][m][0] + bv[bj][0], z1 = acc[ai][bj][m][1] + bv[bj][1]; float o[8];
                    o[0] = __builtin_bit_cast(float, yw.x << 16) * __builtin_amdgcn_rcpf(1.f + __builtin_amdgcn_exp2f(-1.4426950408889634f * z0[0])); o[1] = __builtin_bit_cast(float, yw.x & 0xffff0000u) * __builtin_amdgcn_rcpf(1.f + __builtin_amdgcn_exp2f(-1.4426950408889634f * z0[1]));
                    o[2] = __builtin_bit_cast(float, yw.y << 16) * __builtin_amdgcn_rcpf(1.f + __builtin_amdgcn_exp2f(-1.4426950408889634f * z0[2])); o[3] = __builtin_bit_cast(float, yw.y & 0xffff0000u) * __builtin_amdgcn_rcpf(1.f + __builtin_amdgcn_exp2f(-1.4426950408889634f * z0[3]));
                    o[4] = __builtin_bit_cast(float, yw.z << 16) * __builtin_amdgcn_rcpf(1.f + __builtin_amdgcn_exp2f(-1.4426950408889634f * z1[0])); o[5] = __builtin_bit_cast(float, yw.z & 0xffff0000u) * __builtin_amdgcn_rcpf(1.f + __builtin_amdgcn_exp2f(-1.4426950408889634f * z1[1]));
                    o[6] = __builtin_bit_cast(float, yw.w << 16) * __builtin_amdgcn_rcpf(1.f + __builtin_amdgcn_exp2f(-1.4426950408889634f * z1[2])); o[7] = __builtin_bit_cast(float, yw.w & 0xffff0000u) * __builtin_amdgcn_rcpf(1.f + __builtin_amdgcn_exp2f(-1.4426950408889634f * z1[3]));
                    u32x4 w; w.x = cvt_pk_bf16(o[0], o[1]); w.y = cvt_pk_bf16(o[2], o[3]); w.z = cvt_pk_bf16(o[4], o[5]); w.w = cvt_pk_bf16(o[6], o[7]);
                    *(u32x4*)(O + (size_t)row * ldo + col) = w; } }
            asm volatile("" ::: "memory"); }
    }
};

struct EpiQKU {
    static constexpr bool PERM = true, AFTER_DRAIN = false;
    bf16_t* QB; bf16_t* KB; bf16_t* UX; const float* qg; const float* kg; float qscale, eps;
    __device__ __forceinline__ void operator()(const f32x4 (&acc)[2][2][4][2], const Unit& u, int wr, int wc, int fr, int fq) const {
        const int row0 = u.pm * BM + wr * 64 + fr, kind = u.pn >> 2, lc0 = (u.pn & 3) * BM + 64 * wc + 8 * fq;
        if (kind < 2) {
            const float* gp = kind == 0 ? qg : kg; const float gs = kind == 0 ? qscale : 1.0f; bf16_t* O = kind == 0 ? QB : KB;
            f32x4 gv[2][2];
#pragma unroll
            for (int bj = 0; bj < 2; ++bj) { gv[bj][0] = *(const f32x4*)(gp + 32 * bj + 8 * fq) * gs; gv[bj][1] = *(const f32x4*)(gp + 32 * bj + 8 * fq + 4) * gs; }
#pragma unroll
            for (int ai = 0; ai < 2; ++ai)
#pragma unroll
                for (int m = 0; m < 4; ++m) {
                    float ss = 0.f;
#pragma unroll
                    for (int bj = 0; bj < 2; ++bj)
#pragma unroll
                        for (int n = 0; n < 2; ++n) { const f32x4 x = acc[ai][bj][m][n]; ss += (x[0] * x[0] + x[1] * x[1]) + (x[2] * x[2] + x[3] * x[3]); }
                    ss += __shfl_xor(ss, 16); ss += __shfl_xor(ss, 32);
                    const float rs = rsqrtf(ss * (1.0f / 64.0f) + eps);
                    bf16_t* rowp = O + (size_t)(row0 + ai * HALF + m * 16) * 1024 + lc0;
#pragma unroll
                    for (int bj = 0; bj < 2; ++bj) { const f32x4 v0 = acc[ai][bj][m][0] * rs * gv[bj][0], v1 = acc[ai][bj][m][1] * rs * gv[bj][1];
                        u32x4 w; w.x = cvt_pk_bf16(v0[0], v0[1]); w.y = cvt_pk_bf16(v0[2], v0[3]); w.z = cvt_pk_bf16(v1[0], v1[1]); w.w = cvt_pk_bf16(v1[2], v1[3]);
                        { bf16_t* qp_ = rowp + 32 * bj; asm volatile("global_store_dwordx4 %0, %1, off sc1\n\ts_nop 1" :: "v"(qp_), "v"(w) : "memory"); } }
                }
        } else {
#pragma unroll
            for (int ai = 0; ai < 2; ++ai)
#pragma unroll
                for (int m = 0; m < 4; ++m) { const int row = row0 + ai * HALF + m * 16;
#pragma unroll
                    for (int bj = 0; bj < 2; ++bj) { const int lu = lc0 + 32 * bj, g = lu >> 4, c0 = lu & 15; const f32x4 v0 = acc[ai][bj][m][0], v1 = acc[ai][bj][m][1];
                        u32x4 w; w.x = cvt_pk_bf16(v0[0], v0[1]); w.y = cvt_pk_bf16(v0[2], v0[3]); w.z = cvt_pk_bf16(v1[0], v1[1]); w.w = cvt_pk_bf16(v1[2], v1[3]);
                        { bf16_t* up_ = UX + ((size_t)g * 512 + (row >> 4)) * 384 + (row & 15) * 16 + c0; asm volatile("global_store_dwordx4 %0, %1, off sc1\n\ts_nop 1" :: "v"(up_), "v"(w) : "memory"); } } }
        }
    }
};

__device__ __forceinline__ float dpp_ror1(float v) { return __builtin_bit_cast(float, __builtin_amdgcn_update_dpp(0, __builtin_bit_cast(int, v), 0x121, 0xf, 0xf, false)); }
__device__ __forceinline__ float dpp_ror2(float v) { return __builtin_bit_cast(float, __builtin_amdgcn_update_dpp(0, __builtin_bit_cast(int, v), 0x122, 0xf, 0xf, false)); }
struct EpiUpAct {
    static constexpr bool PERM = true, AFTER_DRAIN = false;
    bf16_t* ACT; bf16_t* sideA; bf16_t* sideB; const float* cw; const float* cbias; int nf;
    __device__ __forceinline__ void operator()(const f32x4 (&acc)[2][2][4][2], const Unit& u, int wr, int wc, int fr, int fq) const {
        const int f0 = u.pn * HALF + wc * 32 + 8 * fq;
        float w0[8], w1[8], w2[8], cb[8];
#pragma unroll
        for (int h = 0; h < 2; ++h) { const f32x4 a = *(const f32x4*)(cw + f0 + 4 * h), b = *(const f32x4*)(cw + nf + f0 + 4 * h), c = *(const f32x4*)(cw + 2 * nf + f0 + 4 * h), d = *(const f32x4*)(cbias + f0 + 4 * h);
#pragma unroll
            for (int e = 0; e < 4; ++e) { w0[4 * h + e] = a[e]; w1[4 * h + e] = b[e]; w2[4 * h + e] = c[e]; cb[4 * h + e] = d[e]; } }
#pragma unroll
        for (int ai = 0; ai < 2; ++ai) {
            const int rowb = u.pm * BM + ai * HALF + wr * 64, blk = rowb >> 6;
#pragma unroll
            for (int m = 0; m < 4; ++m) {
                const int row = rowb + m * 16 + fr;
                float o[8];
#pragma unroll
                for (int e = 0; e < 8; ++e) {
                    const float cur = acc[ai][0][m][e >> 2][e & 3], prv = (m > 0) ? acc[ai][0][m > 0 ? m - 1 : 0][e >> 2][e & 3] : 0.f, gg = acc[ai][1][m][e >> 2][e & 3];
                    const float p1 = dpp_ror1(fr == 15 ? prv : cur), p2 = dpp_ror2(fr >= 14 ? prv : cur);
                    const float x = w0[e] * p2 + w1[e] * p1 + w2[e] * cur + cb[e];
                    const float q = 0.7978845608028654f * (x + 0.044715f * x * x * x);
                    o[e] = x * __builtin_amdgcn_rcpf(1.0f + __builtin_amdgcn_exp2f(-2.885390081777927f * q)) * gg;
                }
                if (m > 0 || fr >= 2) { u32x4 w; w.x = cvt_pk_bf16(o[0], o[1]); w.y = cvt_pk_bf16(o[2], o[3]); w.z = cvt_pk_bf16(o[4], o[5]); w.w = cvt_pk_bf16(o[6], o[7]);
                    *(u32x4*)(ACT + (size_t)row * nf + f0) = w; }
                else { const f32x4 a0 = acc[ai][0][0][0], a1 = acc[ai][0][0][1], g0 = acc[ai][1][0][0], g1 = acc[ai][1][0][1];
                    u32x4 wa, wg; wa.x = cvt_pk_bf16(a0[0], a0[1]); wa.y = cvt_pk_bf16(a0[2], a0[3]); wa.z = cvt_pk_bf16(a1[0], a1[1]); wa.w = cvt_pk_bf16(a1[2], a1[3]);
                    wg.x = cvt_pk_bf16(g0[0], g0[1]); wg.y = cvt_pk_bf16(g0[2], g0[3]); wg.z = cvt_pk_bf16(g1[0], g1[1]); wg.w = cvt_pk_bf16(g1[2], g1[3]);
                    bf16_t* sb = sideB + ((size_t)(blk * 2 + fr) * 2) * nf + f0; *(u32x4*)sb = wa; *(u32x4*)(sb + nf) = wg; }
                if (m == 3 && fr >= 14) { const f32x4 a0 = acc[ai][0][3][0], a1 = acc[ai][0][3][1];
                    u32x4 wa; wa.x = cvt_pk_bf16(a0[0], a0[1]); wa.y = cvt_pk_bf16(a0[2], a0[3]); wa.z = cvt_pk_bf16(a1[0], a1[1]); wa.w = cvt_pk_bf16(a1[2], a1[3]);
                    *(u32x4*)(sideA + (size_t)(blk * 2 + (fr - 14)) * nf + f0) = wa; }
            }
        }
    }
};

struct OneUnit {
    int pm, pn;
    __device__ bool next(int i, Unit& u) const { if (i) return false; u.pm = pm; u.pn = pn; return true; }
    __device__ __forceinline__ void a_ready(const Unit&) const {}
    __device__ __forceinline__ void done(const Unit&) const {}
};

struct EpiResOutB {
    static constexpr bool PERM = true, AFTER_DRAIN = false;
    const float* base; const float* gate; bf16_t* O; int ldc;
    __device__ __forceinline__ void operator()(const f32x4 (&acc)[2][2][4][2], const Unit& u, int wr, int wc, int fr, int fq) const {
        const int row0 = u.pm * BM + wr * 64 + fr, col0 = u.pn * BM + wc * 32 + 8 * fq; const float* gp = gate + ((u.pm * BM) >> 12) * 12288 + col0;
        f32x4 gv[2][2];
#pragma unroll
        for (int bj = 0; bj < 2; ++bj) { gv[bj][0] = *(const f32x4*)(gp + bj * HALF); gv[bj][1] = *(const f32x4*)(gp + bj * HALF + 4); }
#pragma unroll
        for (int ai = 0; ai < 2; ++ai) {
            f32x4 xv[4][2][2];
#pragma unroll
            for (int m = 0; m < 4; ++m) { const size_t off = (size_t)(row0 + ai * HALF + m * 16) * ldc + col0;
#pragma unroll
                for (int bj = 0; bj < 2; ++bj) { xv[m][bj][0] = __builtin_nontemporal_load((const f32x4*)(base + off + bj * HALF)); xv[m][bj][1] = __builtin_nontemporal_load((const f32x4*)(base + off + bj * HALF + 4)); } }
#pragma unroll
            for (int m = 0; m < 4; ++m) { const size_t off = (size_t)(row0 + ai * HALF + m * 16) * ldc + col0;
#pragma unroll
                for (int bj = 0; bj < 2; ++bj) { const f32x4 v0 = xv[m][bj][0] + gv[bj][0] * acc[ai][bj][m][0], v1 = xv[m][bj][1] + gv[bj][1] * acc[ai][bj][m][1];
                    u32x4 w; w.x = cvt_pk_bf16(v0[0], v0[1]); w.y = cvt_pk_bf16(v0[2], v0[3]); w.z = cvt_pk_bf16(v1[0], v1[1]); w.w = cvt_pk_bf16(v1[2], v1[3]);
                    *(u32x4*)(O + off + bj * HALF) = w; } }
            asm volatile("" ::: "memory");
        }
    }
};
struct EpiResInB {
    static constexpr bool PERM = true, AFTER_DRAIN = false;
    const bf16_t* base; const float* gate; float* O; int ldc;
    __device__ __forceinline__ void operator()(const f32x4 (&acc)[2][2][4][2], const Unit& u, int wr, int wc, int fr, int fq) const {
        const int row0 = u.pm * BM + wr * 64 + fr, col0 = u.pn * BM + wc * 32 + 8 * fq; const float* gp = gate + ((u.pm * BM) >> 12) * 12288 + col0;
        f32x4 gv[2][2];
#pragma unroll
        for (int bj = 0; bj < 2; ++bj) { gv[bj][0] = *(const f32x4*)(gp + bj * HALF); gv[bj][1] = *(const f32x4*)(gp + bj * HALF + 4); }
#pragma unroll
        for (int ai = 0; ai < 2; ++ai) {
            u32x4 xw[4][2];
#pragma unroll
            for (int m = 0; m < 4; ++m)
#pragma unroll
                for (int bj = 0; bj < 2; ++bj) xw[m][bj] = *(const u32x4*)(base + (size_t)(row0 + ai * HALF + m * 16) * ldc + col0 + bj * HALF);
#pragma unroll
            for (int m = 0; m < 4; ++m) { const size_t off = (size_t)(row0 + ai * HALF + m * 16) * ldc + col0;
#pragma unroll
                for (int bj = 0; bj < 2; ++bj) { const u32x4 q = xw[m][bj];
                    const f32x4 x0 = {__builtin_bit_cast(float, q.x << 16), __builtin_bit_cast(float, q.x & 0xffff0000u), __builtin_bit_cast(float, q.y << 16), __builtin_bit_cast(float, q.y & 0xffff0000u)};
                    const f32x4 x1 = {__builtin_bit_cast(float, q.z << 16), __builtin_bit_cast(float, q.z & 0xffff0000u), __builtin_bit_cast(float, q.w << 16), __builtin_bit_cast(float, q.w & 0xffff0000u)};
                    __builtin_nontemporal_store(x0 + gv[bj][0] * acc[ai][bj][m][0], (f32x4*)(O + off + bj * HALF)); __builtin_nontemporal_store(x1 + gv[bj][1] * acc[ai][bj][m][1], (f32x4*)(O + off + bj * HALF + 4)); } }
            asm volatile("" ::: "memory");
        }
    }
};
}

#define LAS __attribute__((address_space(3)))
typedef unsigned short bf16_t;
typedef float f32x4 __attribute__((ext_vector_type(4)));
typedef unsigned u32x4 __attribute__((ext_vector_type(4)));
typedef unsigned u32x2 __attribute__((ext_vector_type(2)));

constexpr int BATCH = 2, SEQ = 4096, DM = 2048, NTOK = BATCH * SEQ;
constexpr int NH = 8, HD = 64, VD = 128, NG = 64, DFF = 5632, NQKU = 3072;
constexpr float EPS = 1e-6f, LOG2E = 1.4426950408889634f, C2 = 0.125f * LOG2E;
constexpr int LDS_BYTES = 147456;
constexpr int NTHREADS = 512, NWAVES = 8;

constexpr size_t MiB = (size_t)1 << 20;
constexpr size_t WS_CTL = 0, WS_MOD = 1 * MiB, WS_ZERO_BYTES = 2 * MiB;
constexpr size_t WS_WUP = 2 * MiB, WS_WDN = 46 * MiB, WS_X1 = 68 * MiB, WS_HB = 132 * MiB, WS_APRE = 164 * MiB;
constexpr size_t WS_WIN = 164 * MiB, WS_WGLU = 180 * MiB, WS_WOUT = 358 * MiB  , WS_QB = 190 * MiB, WS_KB = 206 * MiB, WS_VT = 222 * MiB;
constexpr size_t WS_UX = 238 * MiB, WS_MIX = 262 * MiB, WS_YG = 294 * MiB, WS_SBUF = 310 * MiB, WS_AMAT = 326 * MiB, WS_WMAT = 340 * MiB, WS_SIDEA = 348 * MiB, WS_SIDEB = 352 * MiB, WS_END = 366 * MiB;
constexpr size_t WS_SIDE = 64 * 1024;

#define GRID_SYNC_CG() do { asm volatile("s_waitcnt vmcnt(0) lgkmcnt(0)" ::: "memory"); grid.sync(); \
    if (__builtin_amdgcn_readfirstlane((int)(threadIdx.x >> 6)) == 0) { __builtin_amdgcn_fence(__ATOMIC_ACQUIRE, "agent"); asm volatile("s_waitcnt vmcnt(0)" ::: "memory"); } __syncthreads(); } while (0)
#define GRID_SYNC() do { xcd_barrier(xbar); } while (0)
#define XCD_SYNC() do { asm volatile("s_waitcnt vmcnt(0) lgkmcnt(0)" ::: "memory"); __syncthreads(); \
    if (threadIdx.x == 0) { const unsigned old_ = __hip_atomic_fetch_add(ctl + 64 * (20 + vx), 1u, __ATOMIC_RELAXED, __HIP_MEMORY_SCOPE_AGENT), gen_ = old_ / (unsigned)nb; \
        if (old_ + 1u == (gen_ + 1u) * (unsigned)nb) __hip_atomic_fetch_add(ctl + 64 * (28 + vx), 1u, __ATOMIC_RELAXED, __HIP_MEMORY_SCOPE_AGENT); \
        else while (__hip_atomic_load(ctl + 64 * (28 + vx), __ATOMIC_RELAXED, __HIP_MEMORY_SCOPE_AGENT) == gen_) __builtin_amdgcn_s_sleep(1); \
        __builtin_amdgcn_fence(__ATOMIC_ACQUIRE, "agent"); asm volatile("s_waitcnt vmcnt(0)" ::: "memory"); } \
    __syncthreads(); } while (0)

#define XB_TMO      128
#define XB_XCNT(j)  (256  + 64 * (j))
#define XB_XSUB(j)  (1280 + 64 * (j))
#define XB_XGEN(j)  (2304 + 64 * (j))
#define XB_TOP      3328
#define XB_TOPGEN   3392
#define XCD_BAR_WORDS 3456
#define XB_SPIN_CAP (1u << 18)

__device__ __forceinline__ unsigned xb_ld(unsigned* p)              { return __hip_atomic_load(p, __ATOMIC_RELAXED, __HIP_MEMORY_SCOPE_AGENT); }
__device__ __forceinline__ unsigned xb_add(unsigned* p, unsigned v) { return __hip_atomic_fetch_add(p, v, __ATOMIC_RELAXED, __HIP_MEMORY_SCOPE_AGENT); }
__device__ __forceinline__ unsigned xb_xcc_id() { return (unsigned)__builtin_amdgcn_s_getreg((3 << 11) | 20) & 0xFu; }
#define XB_SPIN(cond, bar) do { unsigned _sp = 0; while (cond) { __builtin_amdgcn_s_sleep(1); \
    if ((++_sp & 255u) == 0u) { if (xb_ld(&(bar)[XB_TMO])) break; if (_sp > XB_SPIN_CAP) { atomicAdd(&(bar)[XB_TMO], 1u); break; } } } } while (0)

struct XcdBarrier {
    unsigned* bar; unsigned x;
    volatile LAS unsigned* st;
};

__device__ __forceinline__ XcdBarrier xcd_barrier_post(unsigned* bar, volatile LAS unsigned* st) {
    XcdBarrier b; b.bar = bar; b.x = xb_xcc_id(); b.st = st;
    if (threadIdx.x == 0) (void)xb_add(&bar[XB_XCNT(b.x)], 1u);
    return b;
}
__device__ __forceinline__ void xcd_barrier_complete(unsigned* bar, unsigned x, unsigned& nloc, unsigned& nx) {
    const unsigned G = gridDim.x * gridDim.y * gridDim.z;
    unsigned sum, cnt, mine, sp = 0u;
    for (;;) {
        sum = 0u; cnt = 0u; mine = 0u;
#pragma unroll
        for (unsigned j = 0; j < 16; ++j) { const unsigned c = xb_ld(&bar[XB_XCNT(j)]); sum += c; cnt += (c > 0u) ? 1u : 0u; mine = (j == x) ? c : mine; }
        if (sum == G) break;
        __builtin_amdgcn_s_sleep(1);
        if ((++sp & 255u) == 0u) { if (xb_ld(&bar[XB_TMO])) break; if (sp > XB_SPIN_CAP) { atomicAdd(&bar[XB_TMO], 1u); break; } }
    }
    nloc = mine > 0u ? mine : 1u; nx = cnt > 0u ? cnt : 1u;
}

__device__ __forceinline__ void xcd_barrier(const XcdBarrier& b) {
    asm volatile("s_waitcnt vmcnt(0)" ::: "memory");
    __syncthreads();
    if (threadIdx.x == 0) {
        unsigned* bar = b.bar;
        __builtin_amdgcn_s_waitcnt(0);
        unsigned nloc = b.st[0], nx = b.st[1];
        if (nloc == 0u) { xcd_barrier_complete(bar, b.x, nloc, nx); b.st[0] = nloc; b.st[1] = nx; }
        const unsigned old = xb_add(&bar[XB_XSUB(b.x)], 1u);
        const unsigned gen = old / nloc;
        if (old + 1u == (gen + 1u) * nloc) {
            __builtin_amdgcn_fence(__ATOMIC_RELEASE, "agent");
            asm volatile("s_waitcnt vmcnt(0)" ::: "memory");
            const unsigned og = xb_add(&bar[XB_TOP], 1u);
            const unsigned tg = og / nx;
            if (og + 1u == (tg + 1u) * nx) xb_add(&bar[XB_TOPGEN], 1u);
            else XB_SPIN(xb_ld(&bar[XB_TOPGEN]) == tg, bar);
            __builtin_amdgcn_fence(__ATOMIC_ACQUIRE, "agent");
            xb_add(&bar[XB_XGEN(b.x)], 1u);
            asm volatile("s_waitcnt vmcnt(0)" ::: "memory");
        } else {
            XB_SPIN(xb_ld(&bar[XB_XGEN(b.x)]) == gen, bar);
            __builtin_amdgcn_fence(__ATOMIC_ACQUIRE, "agent");
            asm volatile("s_waitcnt vmcnt(0)" ::: "memory");
        }
    }
    __syncthreads();
}

struct Params { const float* in[29]; float* out; unsigned char* ws; };

enum { I_X = 0, I_C, I_WADA, I_BADA, I_N1G, I_N2G, I_WIN, I_QG, I_KG, I_LQ1, I_LK1, I_LQ2, I_LK2, I_SUBG, I_ARE, I_AIM, I_LOGDT, I_BRE, I_BIM, I_CRE, I_CIM, I_SD,
       I_WGLU, I_BGLU, I_WOUT, I_WUP, I_CONVW, I_CONVB, I_WDN };

__device__ __forceinline__ int opaque_tid() { int t = threadIdx.x; asm volatile("" : "+v"(t)); return t; }
__device__ __forceinline__ float wave_sum(float v) {
#pragma unroll
    for (int o = 1; o < 64; o <<= 1) v += __shfl_xor(v, o);
    return v;
}
__device__ __forceinline__ unsigned f2bf(float f) { unsigned u = __builtin_bit_cast(unsigned, f); return (u + 0x7fffu + ((u >> 16) & 1u)) >> 16; }
__device__ __forceinline__ unsigned pk2(float lo, float hi) { return f2bf(lo) | (f2bf(hi) << 16); }
__device__ __forceinline__ float bf2f(unsigned short h) { return __builtin_bit_cast(float, (unsigned)h << 16); }
__device__ __forceinline__ float bflo(unsigned w) { return __builtin_bit_cast(float, w << 16); }
__device__ __forceinline__ float bfhi(unsigned w) { return __builtin_bit_cast(float, w & 0xffff0000u); }
__device__ __forceinline__ float gelu_tanh(float x) {
    const float u = 0.7978845608028654f * (x + 0.044715f * x * x * x);
    return x * __builtin_amdgcn_rcpf(1.0f + __builtin_amdgcn_exp2f(-2.0f * LOG2E * u));
}
__device__ __forceinline__ float sigmoidf_(float z) { return 1.0f * __builtin_amdgcn_rcpf(1.0f + __builtin_amdgcn_exp2f(-LOG2E * z)); }

__device__ __forceinline__ void transpose_tile(const float* __restrict__ W, int N, bf16_t* __restrict__ WT, int ldt, int k0, int n0, int drow0, LAS float* tile, int tid, int drow1 = -1) {
#pragma unroll
    for (int ps = 0; ps < 2; ++ps) {
        const int kk = ps * 32 + (tid >> 4), nn = (tid & 15) * 4;
        const f32x4 v = *(const f32x4*)(W + (size_t)(k0 + kk) * N + n0 + nn);
        tile[kk * 65 + nn + 0] = v.x; tile[kk * 65 + nn + 1] = v.y; tile[kk * 65 + nn + 2] = v.z; tile[kk * 65 + nn + 3] = v.w;
    }
    __syncthreads();
    const int n = tid >> 3, kc = tid & 7;
    u32x4 o;
    o.x = pk2(tile[(8 * kc + 0) * 65 + n], tile[(8 * kc + 1) * 65 + n]);
    o.y = pk2(tile[(8 * kc + 2) * 65 + n], tile[(8 * kc + 3) * 65 + n]);
    o.z = pk2(tile[(8 * kc + 4) * 65 + n], tile[(8 * kc + 5) * 65 + n]);
    o.w = pk2(tile[(8 * kc + 6) * 65 + n], tile[(8 * kc + 7) * 65 + n]);
    const int drow = (drow1 >= 0 && n >= 32) ? drow1 + (n - 32) : drow0 + n;
    *(u32x4*)(WT + (size_t)drow * ldt + k0 + 8 * kc) = o;
    __syncthreads();
}


__device__ __forceinline__ void transpose_tile_w(const float* __restrict__ W, int N, bf16_t* __restrict__ WT, int ldt, int k0, int n0, int drow0, int drow1, LAS float* wt, int lane) {
    const int rr = lane >> 4, c4 = (lane & 15) * 4;
#pragma unroll
    for (int hf = 0; hf < 2; ++hf) {
        f32x4 v[8];
#pragma unroll
        for (int j = 0; j < 8; ++j) v[j] = __builtin_nontemporal_load((const f32x4*)(W + (size_t)(k0 + (hf * 8 + j) * 4 + rr) * N + n0 + c4));
#pragma unroll
        for (int j = 0; j < 8; ++j) { LAS float* p = wt + ((hf * 8 + j) * 4 + rr) * 65 + c4; p[0] = v[j].x; p[1] = v[j].y; p[2] = v[j].z; p[3] = v[j].w; }
    }
    asm volatile("s_waitcnt lgkmcnt(0)" ::: "memory");
#pragma unroll
    for (int o = 0; o < 8; ++o) {
        const int idx = o * 64 + lane, n = idx >> 3, kc = idx & 7; const LAS float* p = wt + (8 * kc) * 65 + n;
        u32x4 w; w.x = pk2(p[0], p[65]); w.y = pk2(p[2 * 65], p[3 * 65]); w.z = pk2(p[4 * 65], p[5 * 65]); w.w = pk2(p[6 * 65], p[7 * 65]);
        const int drow = (drow1 >= 0 && n >= 32) ? drow1 + (n - 32) : drow0 + n;
        *(u32x4*)(WT + (size_t)drow * ldt + k0 + 8 * kc) = w;
    }
    asm volatile("s_waitcnt lgkmcnt(0)" ::: "memory");
}
constexpr int CT_WIN = 32 * 64, CT_GLU = 16 * 16, CT_OUT = 32 * 32, CT_UP = 32 * 176, CT_DN = 88 * 32;
__device__ __forceinline__ void convert_tile_w(const Params& P, int which, int r, LAS float* wt, int lane) {
    unsigned char* ws = P.ws;
    if (which == 0) { const int kb = r / 64, n0 = (r % 64) * 64;
        if (n0 >= 2048 && n0 < 3072) { transpose_tile_w(P.in[I_WIN], 4096, (bf16_t*)(ws + WS_WIN), 2048, kb * 64, n0, 3072 + (n0 - 2048), -1, wt, lane); return; }
        const int lq = n0 < 2048 ? n0 : 2048 + (n0 - 3072), tb = lq & ~255, wcg = (lq & 255) >> 6;
        transpose_tile_w(P.in[I_WIN], 4096, (bf16_t*)(ws + WS_WIN), 2048, kb * 64, n0, tb + 32 * wcg, tb + 128 + 32 * wcg, wt, lane); return; }
    if (which == 1) { transpose_tile_w(P.in[I_WGLU], 1024, (bf16_t*)(ws + WS_WGLU), 1024, (r / 16) * 64, (r % 16) * 64, (r % 16) * 64, -1, wt, lane); return; }
    if (which == 2) { transpose_tile_w(P.in[I_WOUT], 2048, (bf16_t*)(ws + WS_WOUT), 2048, (r / 32) * 64, (r % 32) * 64, (r % 32) * 64, -1, wt, lane); return; }
    if (which == 3) { const int n0 = (r % 176) * 64, isg = n0 >= DFF, f0 = n0 - isg * DFF;
        transpose_tile_w(P.in[I_WUP], 11264, (bf16_t*)(ws + WS_WUP), 2048, (r / 176) * 64, n0, (f0 >> 7) * 256 + isg * 128 + (f0 & 127), -1, wt, lane); return; }
    transpose_tile_w(P.in[I_WDN], 2048, (bf16_t*)(ws + WS_WDN), 5632, (r / 32) * 64, (r % 32) * 64, (r % 32) * 64, -1, wt, lane);
}

__device__ __forceinline__ void gemv_job(const Params& P, int job, LAS float* red, int tid) {
    const int c4 = tid & 15, rsub = tid >> 4;
    const float* cvec = P.in[I_C];
    const f32x4* W4 = (const f32x4*)P.in[I_WADA] + job * 16 + c4;
    f32x4 a0 = {0.f, 0.f, 0.f, 0.f}, a1 = {0.f, 0.f, 0.f, 0.f};
#pragma unroll 8
    for (int i = 0; i < 64; ++i) {
        const int k = i * 32 + rsub;
        const f32x4 w = __builtin_nontemporal_load(W4 + (size_t)k * 3072);
        const float c0 = cvec[k], c1 = cvec[2048 + k];
        const float s0 = c0 * sigmoidf_(c0), s1 = c1 * sigmoidf_(c1);
        a0 += w * s0; a1 += w * s1;
    }
    LAS f32x4* red4 = (LAS f32x4*)red;
    red4[(rsub * 2 + 0) * 16 + c4] = a0; red4[(rsub * 2 + 1) * 16 + c4] = a1;
    __syncthreads();
    if (tid < 32) {
        const int b = tid >> 4, c = tid & 15;
        f32x4 s = {0.f, 0.f, 0.f, 0.f};
#pragma unroll 8
        for (int r = 0; r < 32; ++r) s += red4[(r * 2 + b) * 16 + c];
        const int col = (job * 16 + c) * 4;
        s += *(const f32x4*)(P.in[I_BADA] + col);
        *(f32x4*)((float*)(P.ws + WS_MOD) + b * 12288 + col) = s;
    }
    __syncthreads();
}

__device__ __forceinline__ void norm_mod_store(const f32x4 (&v)[8], const float* g, const float* shift, const float* scale, bf16_t* orow, int lane) {
    float ss = 0.f;
#pragma unroll
    for (int j = 0; j < 8; ++j) ss += (v[j].x * v[j].x + v[j].y * v[j].y) + (v[j].z * v[j].z + v[j].w * v[j].w);
    ss = wave_sum(ss);
    const float rs = rsqrtf(ss * (1.0f / 2048.0f) + EPS);
#pragma unroll
    for (int j = 0; j < 8; ++j) {
        const int col = 4 * (lane + 64 * j);
        const f32x4 g4 = *(const f32x4*)(g + col), sh = *(const f32x4*)(shift + col), sc = *(const f32x4*)(scale + col);
        const f32x4 h = (v[j] * rs * g4) * (sc + 1.0f) + sh;
        u32x2 o; o.x = pk2(h.x, h.y); o.y = pk2(h.z, h.w);
        *(u32x2*)(orow + col) = o;
    }
}

__device__ __forceinline__ void ssm_abar(const Params& P, int g, int p, float& abr, float& abi, float& cr, float& ci) {
    const float dt = expf(P.in[I_LOGDT][g]);
    const float ar = P.in[I_ARE][g * 64 + p], ai = P.in[I_AIM][g * 64 + p];
    const float mag = expf(dt * ar); abr = mag * cosf(dt * ai); abi = mag * sinf(dt * ai);
    const float den = ar * ar + ai * ai, nr = abr - 1.0f, ni = abi;
    cr = (nr * ar + ni * ai) / den; ci = (ni * ar - nr * ai) / den;
}
__device__ __forceinline__ void ssm_tables_job(const Params& P, int g, LAS float* L, int tid) {
    LAS float* pwr = L;
    LAS float* pwi = L + 17 * 64;
    LAS float* bbr = L + 34 * 64;
    LAS float* bbi = bbr + 1024;
    LAS float* ccr = bbi + 1024;
    LAS float* cci = ccr + 1024;
    LAS float* kk = cci + 1024;
    if (tid < 64) {
        const int p = tid; float abr, abi, cr, ci; ssm_abar(P, g, p, abr, abi, cr, ci);
        float xr = 1.f, xi = 0.f;
        for (int n = 0; n <= 16; ++n) { pwr[n * 64 + p] = xr; pwi[n * 64 + p] = xi; const float nr = xr * abr - xi * abi, ni = xr * abi + xi * abr; xr = nr; xi = ni; }
        for (int c = 0; c < 16; ++c) { const float br = P.in[I_BRE][(g * 64 + p) * 16 + c], bi = P.in[I_BIM][(g * 64 + p) * 16 + c]; bbr[p * 16 + c] = cr * br - ci * bi; bbi[p * 16 + c] = cr * bi + ci * br; }
    }
    for (int i = tid; i < 1024; i += NTHREADS) { ccr[i] = P.in[I_CRE][g * 1024 + i]; cci[i] = P.in[I_CIM][g * 1024 + i]; }
    __syncthreads();
    {
        const int pair = tid & 255, c = pair >> 4, c2 = pair & 15, th = tid >> 8;
        float acc[8];
#pragma unroll
        for (int j = 0; j < 8; ++j) acc[j] = 0.f;
        for (int p = 0; p < 64; ++p) {
            const float cr_ = ccr[c * 64 + p], ci_ = cci[c * 64 + p], br = bbr[p * 16 + c2], bi = bbi[p * 16 + c2];
            const float mr = cr_ * br - ci_ * bi, mi = cr_ * bi + ci_ * br;
#pragma unroll
            for (int j = 0; j < 8; ++j) { const int tau = th * 8 + j; acc[j] += mr * pwr[tau * 64 + p] - mi * pwi[tau * 64 + p]; }
        }
#pragma unroll
        for (int j = 0; j < 8; ++j) kk[(th * 8 + j) * 256 + c * 16 + c2] = acc[j];
    }
    __syncthreads();
    bf16_t* AM = (bf16_t*)(P.ws + WS_AMAT) + (size_t)g * 256 * 384;
    for (int ch = tid; ch < 256 * 48; ch += NTHREADS) {
        const int col = ch / 48, k0 = (ch % 48) * 8, t = col >> 4, c = col & 15; float v[8];
        if (k0 < 256) { const int sidx = k0 >> 4, c2 = k0 & 15;
#pragma unroll
            for (int e = 0; e < 8; ++e) v[e] = (sidx <= t) ? kk[(t - sidx) * 256 + c * 16 + c2 + e] : 0.f;
        } else if (k0 < 320) { const int p0 = k0 - 256;
#pragma unroll
            for (int e = 0; e < 8; ++e) v[e] = ccr[c * 64 + p0 + e] * pwr[(t + 1) * 64 + p0 + e] - cci[c * 64 + p0 + e] * pwi[(t + 1) * 64 + p0 + e];
        } else { const int p0 = k0 - 320;
#pragma unroll
            for (int e = 0; e < 8; ++e) v[e] = -(ccr[c * 64 + p0 + e] * pwi[(t + 1) * 64 + p0 + e] + cci[c * 64 + p0 + e] * pwr[(t + 1) * 64 + p0 + e]);
        }
        u32x4 o; o.x = pk2(v[0], v[1]); o.y = pk2(v[2], v[3]); o.z = pk2(v[4], v[5]); o.w = pk2(v[6], v[7]);
        *(u32x4*)(AM + (size_t)col * 384 + k0) = o;
    }
    bf16_t* WM = (bf16_t*)(P.ws + WS_WMAT) + (size_t)g * 256 * 256;
    for (int ch = tid; ch < 256 * 32; ch += NTHREADS) {
        const int row = ch >> 5, k0 = (ch & 31) * 8, sidx = k0 >> 4, c2 = k0 & 15; float v[8];
#pragma unroll
        for (int e = 0; e < 8; ++e) v[e] = 0.f;
        if (row < 128) { const int p = row & 63; const float wr_ = pwr[(15 - sidx) * 64 + p], wi_ = pwi[(15 - sidx) * 64 + p];
#pragma unroll
            for (int e = 0; e < 8; ++e) { const float br = bbr[p * 16 + c2 + e], bi = bbi[p * 16 + c2 + e]; v[e] = (row < 64) ? (wr_ * br - wi_ * bi) : (wr_ * bi + wi_ * br); } }
        u32x4 o; o.x = pk2(v[0], v[1]); o.y = pk2(v[2], v[3]); o.z = pk2(v[4], v[5]); o.w = pk2(v[6], v[7]);
        *(u32x4*)(WM + (size_t)row * 256 + k0) = o;
    }
    __syncthreads();
}
__device__ __forceinline__ void ssm_carry_job(const Params& P, int g, int b, LAS float* L, int tid) {
    const int p = tid & 63, seg = tid >> 6;
    float abr, abi, cr, ci; ssm_abar(P, g, p, abr, abi, cr, ci);
    float a16r = abr, a16i = abi;
#pragma unroll
    for (int i = 0; i < 4; ++i) { const float nr = a16r * a16r - a16i * a16i, ni = 2.f * a16r * a16i; a16r = nr; a16i = ni; }
    float a512r = a16r, a512i = a16i;
#pragma unroll
    for (int i = 0; i < 5; ++i) { const float nr = a512r * a512r - a512i * a512i, ni = 2.f * a512r * a512i; a512r = nr; a512i = ni; }
    const float* S = (const float*)(P.ws + WS_SBUF) + ((size_t)g * 512 + b * 256 + seg * 32) * 128 + p;
    float xr = 0.f, xi = 0.f;
#pragma unroll 8
    for (int jj = 0; jj < 32; ++jj) { const float sr = S[jj * 128], si = S[jj * 128 + 64]; const float nr = a16r * xr - a16i * xi + sr, ni = a16r * xi + a16i * xr + si; xr = nr; xi = ni; }
    L[seg * 128 + p] = xr; L[seg * 128 + 64 + p] = xi;
    __syncthreads();
    float c0r = 0.f, c0i = 0.f;
    for (int q = 0; q < seg; ++q) { const float er = L[q * 128 + p], ei = L[q * 128 + 64 + p]; const float nr = a512r * c0r - a512i * c0i + er, ni = a512r * c0i + a512i * c0r + ei; c0r = nr; c0i = ni; }
    bf16_t* X = (bf16_t*)(P.ws + WS_UX) + ((size_t)g * 512 + b * 256 + seg * 32) * 384 + 256 + p;
    xr = c0r; xi = c0i;
#pragma unroll 8
    for (int jj = 0; jj < 32; ++jj) {
        X[(size_t)jj * 384] = (bf16_t)f2bf(xr); X[(size_t)jj * 384 + 64] = (bf16_t)f2bf(xi);
        const float sr = S[jj * 128], si = S[jj * 128 + 64]; const float nr = a16r * xr - a16i * xi + sr, ni = a16r * xi + a16i * xr + si; xr = nr; xi = ni;
    }
    __syncthreads();
}

typedef float f32x16 __attribute__((ext_vector_type(16)));
typedef short bf16x8v __attribute__((ext_vector_type(8)));
typedef short s16x4v __attribute__((ext_vector_type(4)));
typedef float f32x2v __attribute__((ext_vector_type(2)));
typedef __bf16 bf16x2v __attribute__((ext_vector_type(2)));
__device__ __forceinline__ unsigned cvtpk(float lo, float hi) { f32x2v v = {lo, hi}; bf16x2v b = __builtin_convertvector(v, bf16x2v); return __builtin_bit_cast(unsigned, b); }
constexpr int AT_KP = 144, AT_VP = 144, AT_K1 = 0, AT_K2 = 64 * AT_KP, AT_V = 2 * 64 * AT_KP, AT_STAGE = AT_V + 128 * AT_VP;

__device__ __forceinline__ void attn_unit(const Params& P, LAS unsigned char* lds, int b, int h, int qb, float lam, float wnd2b, int tid) {
    const int lane = tid & 63, wave = __builtin_amdgcn_readfirstlane(tid >> 6), sm = wave >> 2, rb = wave & 3, l31 = lane & 31, kg = lane >> 5;
    const bf16_t* QB = (const bf16_t*)(P.ws + WS_QB); const bf16_t* KB = (const bf16_t*)(P.ws + WS_KB); const bf16_t* VT = (const bf16_t*)(P.ws + WS_VT);
    bf16_t* MIX = (bf16_t*)(P.ws + WS_MIX);
    const int q0 = qb * 128; const size_t tokb = (size_t)b * SEQ;
    const int qw0 = q0 + 32 * rb, qpos = qw0 + l31;
    bf16x8v qf[4];
    { const bf16_t* qp = QB + (tokb + qpos) * 1024 + h * 128 + sm * 64 + 8 * kg;
#pragma unroll
      for (int ks = 0; ks < 4; ++ks) qf[ks] = __builtin_nontemporal_load((const bf16x8v*)(qp + 16 * ks)); }
    const float sl2 = exp2f(-(float)(h + 1)) * LOG2E;
    float l = 0.f; const float bref = 0.5f * (wnd2b - 64.0f);
    f32x16 o[4];
#pragma unroll
    for (int vb = 0; vb < 4; ++vb)
#pragma unroll
        for (int r = 0; r < 16; ++r) o[vb][r] = 0.f;
    const int NT = 2 * (qb + 1);
    int t0 = (int)floorf(((float)(q0 - 63) - wnd2b / sl2) * (1.0f / 64.0f)) + 1; t0 = t0 < 0 ? 0 : t0;
    const int krow = tid >> 3, kch = tid & 7;
    const bf16_t* kg1 = KB + (tokb + krow) * 1024 + h * 128 + kch * 8;
    const bf16_t* vg0 = VT + (size_t)(h * 128 + krow) * NTOK + tokb + kch * 8;
    const bf16_t* vg1 = vg0 + (size_t)64 * NTOK;
    const int kofs = krow * AT_KP + kch * 16, vofs0 = AT_V + krow * AT_VP + ((kch >> 1) * 16 + (kch & 1) * 4) * 2, vofs1 = vofs0 + 64 * AT_VP;
    u32x4 rk1, rk2, rv0, rv1;
#define AT_LOAD(t) do { const bf16_t* kp_ = kg1 + (size_t)(t) * 64 * 1024; rk1 = *(const u32x4*)kp_; rk2 = *(const u32x4*)(kp_ + 64); rv0 = *(const u32x4*)(vg0 + (t) * 64); rv1 = *(const u32x4*)(vg1 + (t) * 64); } while (0)
#define AT_STORE(base) do { *(LAS u32x4*)((base) + AT_K1 + kofs) = rk1; *(LAS u32x4*)((base) + AT_K2 + kofs) = rk2; \
        *(LAS u32x2*)((base) + vofs0) = (u32x2){rv0.x, rv0.y}; *(LAS u32x2*)((base) + vofs0 + 16) = (u32x2){rv0.z, rv0.w}; \
        *(LAS u32x2*)((base) + vofs1) = (u32x2){rv1.x, rv1.y}; *(LAS u32x2*)((base) + vofs1 + 16) = (u32x2){rv1.z, rv1.w}; } while (0)
    AT_LOAD(t0); AT_STORE(lds + (t0 & 1) * AT_STAGE); __syncthreads();
    for (int t = t0; t < NT; ++t) {
        LAS unsigned char* cur = lds + (t & 1) * AT_STAGE; LAS unsigned char* nxt = lds + ((t + 1) & 1) * AT_STAGE;
        if (t + 1 < NT) AT_LOAD(t + 1);
        const int kv0 = t * 64;
        if (kv0 <= qw0 + 31) {
            f32x16 p0, p1;
            { const float cbase = sl2 * (float)(kv0 + 4 * kg - qpos) - bref, s32 = 32.f * sl2;
#pragma unroll
              for (int r = 0; r < 16; ++r) { p0[r] = cbase + sl2 * (float)((r & 3) + 8 * (r >> 2)); p1[r] = p0[r] + s32; } }
            const LAS unsigned char* kb = cur + (sm ? AT_K2 : AT_K1) + l31 * AT_KP + kg * 16;
            __builtin_amdgcn_s_setprio(1);
#pragma unroll
            for (int ks = 0; ks < 4; ++ks) {
                const bf16x8v a0 = *(const LAS bf16x8v*)(kb + ks * 32), a1 = *(const LAS bf16x8v*)(kb + 32 * AT_KP + ks * 32);
                p0 = __builtin_amdgcn_mfma_f32_32x32x16_bf16(a0, qf[ks], p0, 0, 0, 0);
                p1 = __builtin_amdgcn_mfma_f32_32x32x16_bf16(a1, qf[ks], p1, 0, 0, 0);
            }
            __builtin_amdgcn_s_setprio(0);
            if (kv0 + 63 > qw0) {
                const int kb0 = kv0 + 4 * kg;
#pragma unroll
                for (int r = 0; r < 16; ++r) { const int kvp = kb0 + (r & 3) + 8 * (r >> 2); if (kvp > qpos) p0[r] = -INFINITY; if (kvp + 32 > qpos) p1[r] = -INFINITY; }
            }
            float ps = 0.f;
#pragma unroll
            for (int r = 0; r < 16; ++r) { p0[r] = __builtin_amdgcn_exp2f(p0[r]); p1[r] = __builtin_amdgcn_exp2f(p1[r]); ps += p0[r] + p1[r]; }
            l += ps;
            bf16x8v pb[4];
            { u32x4 w;
              w.x = cvtpk(p0[0], p0[1]); w.y = cvtpk(p0[2], p0[3]); w.z = cvtpk(p0[4], p0[5]); w.w = cvtpk(p0[6], p0[7]); pb[0] = __builtin_bit_cast(bf16x8v, w);
              w.x = cvtpk(p0[8], p0[9]); w.y = cvtpk(p0[10], p0[11]); w.z = cvtpk(p0[12], p0[13]); w.w = cvtpk(p0[14], p0[15]); pb[1] = __builtin_bit_cast(bf16x8v, w);
              w.x = cvtpk(p1[0], p1[1]); w.y = cvtpk(p1[2], p1[3]); w.z = cvtpk(p1[4], p1[5]); w.w = cvtpk(p1[6], p1[7]); pb[2] = __builtin_bit_cast(bf16x8v, w);
              w.x = cvtpk(p1[8], p1[9]); w.y = cvtpk(p1[10], p1[11]); w.z = cvtpk(p1[12], p1[13]); w.w = cvtpk(p1[14], p1[15]); pb[3] = __builtin_bit_cast(bf16x8v, w); }
            const LAS unsigned char* vbp = cur + AT_V + l31 * AT_VP + kg * 16;
            __builtin_amdgcn_s_setprio(1);
#pragma unroll
            for (int vb = 0; vb < 4; ++vb)
#pragma unroll
                for (int k2 = 0; k2 < 4; ++k2) {
                    const bf16x8v av = *(const LAS bf16x8v*)(vbp + vb * 32 * AT_VP + k2 * 32);
                    o[vb] = __builtin_amdgcn_mfma_f32_32x32x16_bf16(av, pb[k2], o[vb], 0, 0, 0);
                }
            __builtin_amdgcn_s_setprio(0);
        }
        if (t + 1 < NT) AT_STORE(nxt);
        __syncthreads();
    }
#undef AT_LOAD
#undef AT_STORE
    const float inv = 1.0f / (l + __shfl_xor(l, 32));
    LAS float* ob = (LAS float*)lds;
    if (sm == 1) {
#pragma unroll
        for (int vb = 0; vb < 4; ++vb)
#pragma unroll
            for (int r = 0; r < 16; ++r) ob[((rb * 4 + vb) * 16 + r) * 64 + lane] = o[vb][r] * inv;
    }
    __syncthreads();
    if (sm == 0) {
        float ss = 0.f;
#pragma unroll
        for (int vb = 0; vb < 4; ++vb)
#pragma unroll
            for (int r = 0; r < 16; ++r) { const float d = o[vb][r] * inv - lam * ob[((rb * 4 + vb) * 16 + r) * 64 + lane]; o[vb][r] = d; ss += d * d; }
        ss += __shfl_xor(ss, 32);
        const float rn = rsqrtf(ss * (1.0f / 128.0f) + EPS) * 0.8f;
        const float* gs = P.in[I_SUBG];
        bf16_t* mp = MIX + (tokb + qpos) * 2048 + h * 128;
#pragma unroll
        for (int vb = 0; vb < 4; ++vb)
#pragma unroll
            for (int r4 = 0; r4 < 4; ++r4) {
                const int vc = 32 * vb + 8 * r4 + 4 * kg; const f32x4 g4 = *(const f32x4*)(gs + vc);
                u32x2 w; w.x = cvtpk(o[vb][4 * r4 + 0] * rn * g4.x, o[vb][4 * r4 + 1] * rn * g4.y); w.y = cvtpk(o[vb][4 * r4 + 2] * rn * g4.z, o[vb][4 * r4 + 3] * rn * g4.w);
                *(u32x2*)(mp + vc) = w;
            }
    }
    __syncthreads();
}

constexpr int LATE_SPLIT = 288;
#define LATE_W_ITEM(done_, cw_, lo_, hi_) do { \
        constexpr int J_OUT_ = 32 * 32, J_UP_ = 32 * 176, J_LATE_ = J_OUT_ + J_UP_;     \
        const int tid_ = opaque_tid(); \
        if (tid_ == 0) lctl[3] = __hip_atomic_fetch_add(ctl + 64 * (cw_), 1u, __ATOMIC_RELAXED, __HIP_MEMORY_SCOPE_AGENT); \
        __syncthreads(); \
        const int it_ = (lo_) + __builtin_amdgcn_readfirstlane((int)lctl[3]); \
        __syncthreads(); \
        if (it_ >= (hi_) || it_ * 16 >= J_LATE_) { done_ = true; break; } \
        { const int w_ = __builtin_amdgcn_readfirstlane(tid_ >> 6), ln_ = tid_ & 63; \
          for (int q_ = 0; q_ < 2; ++q_) { const int r_ = it_ * 16 + q_ * 8 + w_; if (r_ < J_LATE_) { if (r_ < J_OUT_) convert_tile_w(P, 2, r_, ldsf + w_ * (64 * 65), ln_); else convert_tile_w(P, 3, r_ - J_OUT_, ldsf + w_ * (64 * 65), ln_); } } } \
        __syncthreads(); } while (0)

#define WDN_QUEUE() do { for (;;) { const int tid_ = opaque_tid(); \
        if (tid_ == 0) lctl[3] = __hip_atomic_fetch_add(ctl + 64 * 13, 1u, __ATOMIC_RELAXED, __HIP_MEMORY_SCOPE_AGENT); \
        __syncthreads(); \
        const int it_ = __builtin_amdgcn_readfirstlane((int)lctl[3]); \
        __syncthreads(); \
        if (it_ * 8 >= 88 * 32) break; \
        { const int w_ = __builtin_amdgcn_readfirstlane(tid_ >> 6); convert_tile_w(P, 4, it_ * 8 + w_, ldsf + w_ * (64 * 65), tid_ & 63); } __syncthreads(); } } while (0)

__global__ void __launch_bounds__(NTHREADS, 2) fwd_kernel(Params P) {
    extern __shared__ __attribute__((aligned(16))) unsigned char lds_raw[];
    cg::grid_group grid = cg::this_grid();
    LAS unsigned char* lds = (LAS unsigned char*)lds_raw;
    LAS float* ldsf = (LAS float*)lds_raw;
    const int tid = threadIdx.x, lane = tid & 63, wave = __builtin_amdgcn_readfirstlane(tid >> 6);
    const int G = gridDim.x, bid = blockIdx.x;
    unsigned* ctl = (unsigned*)(P.ws + WS_CTL);
    LAS unsigned* lctl = (LAS unsigned*)(lds_raw + LDS_BYTES - 256);
    if (tid == 0) { lctl[4] = 0u; lctl[5] = 0u; }
    if (bid == 0) {
        u32x4* z = (u32x4*)ctl;
        for (int i = tid; i < 65536 / 16; i += NTHREADS) z[i] = (u32x4){0u, 0u, 0u, 0u};
        asm volatile("s_waitcnt vmcnt(0)" ::: "memory");
    }
    __syncthreads();
    grid.sync();
    XcdBarrier xbar = xcd_barrier_post(ctl + 4096, (volatile LAS unsigned*)(lctl + 4));
    if (tid == 0) { const unsigned x = ((unsigned)__builtin_amdgcn_s_getreg((3 << 11) | 20)) & 7u; lctl[0] = x; lctl[1] = __hip_atomic_fetch_add(ctl + 64 * x, 1u, __ATOMIC_RELAXED, __HIP_MEMORY_SCOPE_AGENT); }
    __syncthreads();
    const int vx = __builtin_amdgcn_readfirstlane((int)lctl[0]), rank = __builtin_amdgcn_readfirstlane((int)lctl[1]);
    unsigned char* ws = P.ws;
    bf16_t* WUP = (bf16_t*)(ws + WS_WUP); bf16_t* WDN = (bf16_t*)(ws + WS_WDN); float* X1 = (float*)(ws + WS_X1); bf16_t* HB = (bf16_t*)(ws + WS_HB);
    bf16_t* APRE = (bf16_t*)(ws + WS_APRE); bf16_t* WIN = (bf16_t*)(ws + WS_WIN); bf16_t* WGLU = (bf16_t*)(ws + WS_WGLU); bf16_t* WOUT = (bf16_t*)(ws + WS_WOUT);
    bf16_t* QB = (bf16_t*)(ws + WS_QB); bf16_t* KB = (bf16_t*)(ws + WS_KB); bf16_t* VT = (bf16_t*)(ws + WS_VT); bf16_t* UX = (bf16_t*)(ws + WS_UX);
    bf16_t* MIX = (bf16_t*)(ws + WS_MIX); bf16_t* YG = (bf16_t*)(ws + WS_YG);
    const float* MOD = (const float*)(ws + WS_MOD);

    {
        const int tid = opaque_tid(), lane = tid & 63, wave = __builtin_amdgcn_readfirstlane(tid >> 6); const int lw = rank * NWAVES + wave, lt = rank * NTHREADS + tid; (void)lane; (void)lw; (void)lt;
        constexpr int J_GEMV = 192, J_T8 = (CT_WIN + CT_GLU) / 8;
        constexpr int J_TOTAL = 64 + J_GEMV + J_T8;
        const bool split = G >= 128;
        for (int k_ = 0; ; ++k_) {
            int job;
            if (!split) job = bid + k_ * G;
            else if (bid < 64) { if (k_ > 0) break; job = bid; }
            else job = 64 + (bid - 64) + k_ * (G - 64);
            if (job >= J_TOTAL) break;
            int r = job;
            if (r < 64) { ssm_tables_job(P, r, ldsf, tid); continue; } r -= 64;
            if (r < J_GEMV) { gemv_job(P, r, ldsf, tid); continue; } r -= J_GEMV;
            const int tl = r * 8 + wave;
            if (tl < CT_WIN) convert_tile_w(P, 0, tl, ldsf + wave * (64 * 65), lane); else convert_tile_w(P, 1, tl - CT_WIN, ldsf + wave * (64 * 65), lane);
        }
    }
    GRID_SYNC();
    const int nb = __builtin_amdgcn_readfirstlane((int)__hip_atomic_load(ctl + 64 * vx, __ATOMIC_RELAXED, __HIP_MEMORY_SCOPE_AGENT));
    const int NLW = nb * NWAVES, row_base = vx * 1024, NLT = nb * NTHREADS;

    { const int tid = opaque_tid(), lane = tid & 63, wave = __builtin_amdgcn_readfirstlane(tid >> 6); const int lw = rank * NWAVES + wave, lt = rank * NTHREADS + tid; (void)lane; (void)lw; (void)lt;
    for (int lr = lw; lr < 1024; lr += NLW) { const int row = row_base + lr;
        const int b = row >> 12;
        const f32x4* xr = (const f32x4*)(P.in[I_X] + (size_t)row * DM);
        f32x4 v[8];
#pragma unroll
        for (int j = 0; j < 8; ++j) v[j] = __builtin_nontemporal_load(xr + lane + 64 * j);
        norm_mod_store(v, P.in[I_N1G], MOD + b * 12288 + 0, MOD + b * 12288 + 2048, HB + (size_t)row * DM, lane);
    }
    }
    XCD_SYNC();
    {
        pg8::Gemm g{HB, WIN, NTOK, NQKU, DM, DM, DM}; pg8::XcdOrder S; S.init(NTOK, NQKU, vx, rank, nb);
        pg8::EpiQKU E{QB, KB, UX, P.in[I_QG], P.in[I_KG], C2, EPS};
        pg8::gemm_phase<pg8::EpiQKU, pg8::XcdOrder, true, true>(lds, g, S, E);
    }
    {
        pg8::Gemm g{WIN + (size_t)3072 * DM, HB, 1024, NTOK, DM, DM, DM}; pg8::VtOrder S; S.init(vx, rank, nb);
        pg8::EpiBf16<0> E{VT, NTOK, nullptr, 0, 0, 1.f};
        pg8::gemm_phase<pg8::EpiBf16<0>, pg8::VtOrder, true, true>(lds, g, S, E);
    }
    GRID_SYNC();
    for (;;) {
        const int tid = opaque_tid();
        if (tid == 0) lctl[2] = __hip_atomic_fetch_add(ctl + 64 * 9, 1u, __ATOMIC_RELAXED, __HIP_MEMORY_SCOPE_AGENT);
        __syncthreads();
        const int u0 = __builtin_amdgcn_readfirstlane((int)lctl[2]);
        __syncthreads();
        if (u0 >= 128) break;
        const int sg = u0 >> 1, sb = u0 & 1;
        { int kS = 256; asm volatile("" : "+s"(kS));
          pg8::Gemm g{UX, (const bf16_t*)(ws + WS_WMAT), 64 * 512, 256, kS, 384, 256}; pg8::OneUnit S{u0, sg}; pg8::EpiS E{(float*)(ws + WS_SBUF)};
          pg8::gemm_phase<pg8::EpiS, pg8::OneUnit, true, true>(lds, g, S, E); }
        asm volatile("s_waitcnt vmcnt(0) lgkmcnt(0)" ::: "memory"); __syncthreads();
        ssm_carry_job(P, sg, sb, ldsf, opaque_tid());
        asm volatile("s_waitcnt vmcnt(0) lgkmcnt(0)" ::: "memory"); __syncthreads();
        { int kY = 384; asm volatile("" : "+s"(kY));
          pg8::Gemm g{UX, (const bf16_t*)(ws + WS_AMAT), 64 * 512, 256, kY, 384, 384}; pg8::OneUnit S{u0, sg}; pg8::EpiY E{UX, P.in[I_SD], YG};
          pg8::gemm_phase<pg8::EpiY, pg8::OneUnit, true, true>(lds, g, S, E); }
        asm volatile("s_waitcnt vmcnt(0) lgkmcnt(0)" ::: "memory"); __syncthreads();
        if (opaque_tid() == 0) {
            __builtin_amdgcn_fence(__ATOMIC_RELEASE, "agent"); asm volatile("s_waitcnt vmcnt(0)" ::: "memory");
            __hip_atomic_fetch_add(ctl + 64 * (16 + sb), 1u, __ATOMIC_RELAXED, __HIP_MEMORY_SCOPE_AGENT); }
    }
    {
        const int tid = opaque_tid(), lane = tid & 63;
        float lam, wnd2b;
        { const float a = wave_sum(P.in[I_LQ1][lane] * P.in[I_LK1][lane]), b2 = wave_sum(P.in[I_LQ2][lane] * P.in[I_LK2][lane]); lam = expf(a) - expf(b2) + 0.2f; }
        { float gq = fabsf(P.in[I_QG][lane]), gk = fabsf(P.in[I_KG][lane]);
#pragma unroll
          for (int o_ = 1; o_ < 64; o_ <<= 1) { gq = fmaxf(gq, __shfl_xor(gq, o_)); gk = fmaxf(gk, __shfl_xor(gk, o_)); }
          wnd2b = 2.0f * (8.0f * gq * gk * LOG2E * 1.02f) + 64.0f; }
        bool late_w_done = false;
        for (;;) {
            if (tid == 0) lctl[2] = __hip_atomic_fetch_add(ctl + 64 * 10, 1u, __ATOMIC_RELAXED, __HIP_MEMORY_SCOPE_AGENT);
            __syncthreads();
            const int u = __builtin_amdgcn_readfirstlane((int)lctl[2]);
            __syncthreads();
            if (u >= BATCH * NH * 32) break;
            attn_unit(P, lds, (u & 15) >> 3, u & 7, 31 - (u >> 4), lam, wnd2b, tid);
            if (!late_w_done) LATE_W_ITEM(late_w_done, 15, 0, LATE_SPLIT);
        }
    }
    for (;;) {
        const int tid = opaque_tid();
        if (tid == 0) lctl[2] = __hip_atomic_fetch_add(ctl + 64 * 14, 1u, __ATOMIC_RELAXED, __HIP_MEMORY_SCOPE_AGENT);
        __syncthreads();
        const int t = __builtin_amdgcn_readfirstlane((int)lctl[2]);
        __syncthreads();
        if (t >= 128) break;
        const int pm = t >> 2, pn = t & 3;
        if (tid == 0) {
            while (__hip_atomic_load(ctl + 64 * (16 + (pm >> 4)), __ATOMIC_RELAXED, __HIP_MEMORY_SCOPE_AGENT) < 64u) __builtin_amdgcn_s_sleep(8);
            __builtin_amdgcn_fence(__ATOMIC_ACQUIRE, "agent"); asm volatile("s_waitcnt vmcnt(0)" ::: "memory"); }
        __syncthreads();
        { pg8::Gemm g{YG, WGLU, NTOK, 1024, 1024, 1024, 1024}; pg8::OneUnit S{pm, pn}; pg8::EpiGlu E{YG, 1024, P.in[I_BGLU], MIX + 1024, 2048};
          pg8::gemm_phase<pg8::EpiGlu, pg8::OneUnit, true, true>(lds, g, S, E); }
        asm volatile("s_waitcnt vmcnt(0) lgkmcnt(0)" ::: "memory"); __syncthreads();
    }
    { bool late_done = false;
      while (!late_done) LATE_W_ITEM(late_done, 18, LATE_SPLIT, 416);
      late_done = false; while (!late_done) LATE_W_ITEM(late_done, 15, 0, LATE_SPLIT); }
    GRID_SYNC();
    {
        pg8::Gemm g{MIX, WOUT, NTOK, DM, DM, DM, DM}; pg8::XcdOrder S; S.init(NTOK, DM, vx, rank, nb);
        pg8::EpiResOutB E{P.in[I_X], MOD + 4096, (bf16_t*)X1, DM};
        pg8::gemm_phase<pg8::EpiResOutB, pg8::XcdOrder, true, true>(lds, g, S, E);
    }
    XCD_SYNC();
    { const int tid = opaque_tid(), lane = tid & 63, wave = __builtin_amdgcn_readfirstlane(tid >> 6); const int lw = rank * NWAVES + wave, lt = rank * NTHREADS + tid; (void)lane; (void)lw; (void)lt;
    for (int lr = lw; lr < 1024; lr += NLW) { const int row = row_base + lr;
        const int b = row >> 12;
        const u32x2* x1r = (const u32x2*)((const bf16_t*)X1 + (size_t)row * DM);
        f32x4 v[8];
#pragma unroll
        for (int j = 0; j < 8; ++j) { const u32x2 q = x1r[lane + 64 * j]; v[j] = (f32x4){bflo(q.x), bfhi(q.x), bflo(q.y), bfhi(q.y)}; }
        norm_mod_store(v, P.in[I_N2G], MOD + b * 12288 + 6144, MOD + b * 12288 + 8192, HB + (size_t)row * DM, lane);
    }
    }
    XCD_SYNC();
    bf16_t* ACT = APRE;
    {
        pg8::Gemm g{HB, WUP, NTOK, 2 * DFF, DM, DM, DM}; pg8::XcdOrder S; S.init(NTOK, 2 * DFF, vx, rank, nb);
        pg8::EpiUpAct E{ACT, (bf16_t*)(ws + WS_SIDEA), (bf16_t*)(ws + WS_SIDEB), P.in[I_CONVW], P.in[I_CONVB], DFF};
        pg8::gemm_phase<pg8::EpiUpAct, pg8::XcdOrder, true, true>(lds, g, S, E);
        WDN_QUEUE();
    }
    GRID_SYNC();
    { const int tid = opaque_tid(); const int lt = rank * NTHREADS + tid;
    for (int lj = lt; lj < 16 * 704; lj += NLT) {
        const int fv = lj % 704, blk = vx * 16 + lj / 704, f0 = fv * 8, t0 = blk * 64;
        const bf16_t* sA = (const bf16_t*)(ws + WS_SIDEA); const bf16_t* sB = (const bf16_t*)(ws + WS_SIDEB) + (size_t)blk * 4 * DFF + f0;
        u32x4 pm2 = {0u, 0u, 0u, 0u}, pm1 = {0u, 0u, 0u, 0u};
        if ((t0 & 4095) != 0) { const bf16_t* p = sA + (size_t)(blk - 1) * 2 * DFF + f0; pm2 = *(const u32x4*)p; pm1 = *(const u32x4*)(p + DFF); }
        const u32x4 qa0 = *(const u32x4*)sB, qg0 = *(const u32x4*)(sB + DFF), qa1 = *(const u32x4*)(sB + 2 * DFF), qg1 = *(const u32x4*)(sB + 3 * DFF);
        float am2[8], am1[8], a0[8], g0[8], a1[8], g1[8], o0[8], o1[8];
#define UNPK(dst, V_) do { dst[0] = bflo(V_.x); dst[1] = bfhi(V_.x); dst[2] = bflo(V_.y); dst[3] = bfhi(V_.y); dst[4] = bflo(V_.z); dst[5] = bfhi(V_.z); dst[6] = bflo(V_.w); dst[7] = bfhi(V_.w); } while (0)
        UNPK(am2, pm2); UNPK(am1, pm1); UNPK(a0, qa0); UNPK(g0, qg0); UNPK(a1, qa1); UNPK(g1, qg1);
#undef UNPK
#pragma unroll
        for (int h = 0; h < 2; ++h) { const f32x4 c0 = *(const f32x4*)(P.in[I_CONVW] + f0 + 4 * h), c1 = *(const f32x4*)(P.in[I_CONVW] + DFF + f0 + 4 * h), c2 = *(const f32x4*)(P.in[I_CONVW] + 2 * DFF + f0 + 4 * h), bb = *(const f32x4*)(P.in[I_CONVB] + f0 + 4 * h);
#pragma unroll
            for (int e4 = 0; e4 < 4; ++e4) { const int e = 4 * h + e4;
                o0[e] = gelu_tanh(c0[e4] * am2[e] + c1[e4] * am1[e] + c2[e4] * a0[e] + bb[e4]) * g0[e];
                o1[e] = gelu_tanh(c0[e4] * am1[e] + c1[e4] * a0[e] + c2[e4] * a1[e] + bb[e4]) * g1[e]; } }
        u32x4 w0, w1; w0.x = pk2(o0[0], o0[1]); w0.y = pk2(o0[2], o0[3]); w0.z = pk2(o0[4], o0[5]); w0.w = pk2(o0[6], o0[7]);
        w1.x = pk2(o1[0], o1[1]); w1.y = pk2(o1[2], o1[3]); w1.z = pk2(o1[4], o1[5]); w1.w = pk2(o1[6], o1[7]);
        *(u32x4*)(ACT + (size_t)t0 * DFF + f0) = w0; *(u32x4*)(ACT + (size_t)(t0 + 1) * DFF + f0) = w1;
    }
    }
    XCD_SYNC();

    {
        pg8::Gemm g{ACT, WDN, NTOK, DM, DFF, DFF, DFF}; pg8::XcdOrder S; S.init(NTOK, DM, vx, rank, nb);
        pg8::EpiResInB E{(const bf16_t*)X1, MOD + 10240, P.out, DM};
        pg8::gemm_phase<pg8::EpiResInB, pg8::XcdOrder, true, true>(lds, g, S, E);
    }
}

extern "C" void kernel_launch(void* const* d_in, const int* in_sizes, int n_in, void* d_out, int out_size, void* d_ws, size_t ws_size, hipStream_t stream) {
    static int grid_blocks = 0;
    if (grid_blocks == 0) {
        if (n_in != 29 || ws_size < WS_END) { fprintf(stderr, "kernel_launch: unexpected n_in %d or ws_size %zu\n", n_in, ws_size); grid_blocks = -1; return; }
        int dev = 0, cus = 0, per_cu = 0;
        hipGetDevice(&dev);
        hipDeviceGetAttribute(&cus, hipDeviceAttributeMultiprocessorCount, dev);
        if (hipFuncSetAttribute((const void*)fwd_kernel, hipFuncAttributeMaxDynamicSharedMemorySize, LDS_BYTES) != hipSuccess) fprintf(stderr, "hipFuncSetAttribute failed\n");
        if (hipOccupancyMaxActiveBlocksPerMultiprocessor(&per_cu, (const void*)fwd_kernel, NTHREADS, LDS_BYTES) != hipSuccess || per_cu < 1) { fprintf(stderr, "occupancy query: %d\n", per_cu); per_cu = 1; }
        (void)hipGetLastError();
        grid_blocks = cus;
    }
    if (grid_blocks < 0) return;
    Params p{};
    for (int i = 0; i < 29; ++i) p.in[i] = (const float*)d_in[i];
    p.out = (float*)d_out; p.ws = (unsigned char*)d_ws;
    void* args[] = {&p};
    hipError_t e = hipLaunchCooperativeKernel((const void*)fwd_kernel, dim3(grid_blocks), dim3(NTHREADS), args, LDS_BYTES, stream);
    if (e != hipSuccess) fprintf(stderr, "cooperative launch failed: %s (grid %d)\n", hipGetErrorString(e), grid_blocks);
}
```
